# Optimizing an MI355X kernel written in HIP

```python
import math
import jax, jax.numpy as jnp
from jax import lax
import numpy as np

D_MODEL = 1024
BATCH = 2
SEQ = 8192
DEPTH = 1
DEC_BATCH = 32
DEC_SEQ = 2048
PAST_LEN = 128

GRID_W = 64
Q_BLOCK = 128
A_HEADS = 8
A_QK_DIM = 64
A_V_DIM = 2 * A_QK_DIM
B_HEADS = 8
B_KV_HEADS = 2
B_HEAD_DIM = 128
B_GROUP = B_HEADS // B_KV_HEADS
ROPE_THETA = 10000.0
ROPE_AXIS_DIM = B_HEAD_DIM // 2
REL_BUCKETS = 32
REL_MAX_DIST = 128
D_FF = -(-8 * D_MODEL // (3 * 256)) * 256
LN_EPS = 1e-5
RMS_EPS = 1e-6
DEEPNORM_ALPHA = (2 * DEPTH) ** 0.25
DEEPNORM_BETA = (8 * DEPTH) ** -0.25

A_Q_W = A_HEADS * 2 * A_QK_DIM
A_K_W = A_HEADS * 2 * A_QK_DIM
A_V_W = A_HEADS * A_V_DIM
B_Q_W = B_HEADS * B_HEAD_DIM
B_KV_W = B_KV_HEADS * B_HEAD_DIM
GATE_W = D_MODEL
IN_WIDTHS = [A_Q_W, A_K_W, A_V_W, B_Q_W, B_KV_W, B_KV_W, GATE_W, GATE_W]
IN_TOTAL = sum(IN_WIDTHS)
IN_SPLITS = [int(v) for v in np.cumsum(IN_WIDTHS)[:-1]]

kernel_name = "hybrid_diffattn_axialgqa_deepnorm_encoder"


def layer_norm(x, g, b):
    xf = x.astype(jnp.float32)
    mu = jnp.mean(xf, axis=-1, keepdims=True)
    var = jnp.mean(jnp.square(xf - mu), axis=-1, keepdims=True)
    return ((xf - mu) * lax.rsqrt(var + LN_EPS) * g.astype(jnp.float32) + b.astype(jnp.float32)).astype(x.dtype)


def rms_norm(x, g):
    xf = x.astype(jnp.float32)
    ms = jnp.mean(jnp.square(xf), axis=-1, keepdims=True)
    return (xf * lax.rsqrt(ms + RMS_EPS) * g.astype(jnp.float32)).astype(x.dtype)


def t5_bucket(rel):
    nb = REL_BUCKETS // 2
    max_exact = nb // 2
    ret = (rel > 0).astype(jnp.int32) * nb
    n = jnp.abs(rel)
    nf = jnp.maximum(n, 1).astype(jnp.float32)
    large = max_exact + (jnp.log(nf / max_exact) / math.log(REL_MAX_DIST / max_exact)
                         * (nb - max_exact)).astype(jnp.int32)
    large = jnp.minimum(large, nb - 1)
    return ret + jnp.where(n < max_exact, n, large)


def axial_rope_tables(S):
    rows = S // GRID_W
    row = jnp.repeat(jnp.arange(rows), GRID_W).astype(jnp.float32)
    col = jnp.tile(jnp.arange(GRID_W), rows).astype(jnp.float32)
    freqs = ROPE_THETA ** (-jnp.arange(0, ROPE_AXIS_DIM, 2, dtype=jnp.float32) / ROPE_AXIS_DIM)
    ang_r = row[:, None] * freqs[None, :]
    ang_c = col[:, None] * freqs[None, :]
    cos = jnp.concatenate([jnp.cos(ang_r), jnp.cos(ang_r), jnp.cos(ang_c), jnp.cos(ang_c)], axis=-1)
    sin = jnp.concatenate([jnp.sin(ang_r), jnp.sin(ang_r), jnp.sin(ang_c), jnp.sin(ang_c)], axis=-1)
    return cos, sin


def apply_axial_rope(x, cos, sin):
    half = ROPE_AXIS_DIM // 2
    xs = x.reshape(x.shape[:-1] + (2, 2, half))
    rot = jnp.stack([-xs[..., 1, :], xs[..., 0, :]], axis=-2).reshape(x.shape)
    c = cos[None, :, None, :].astype(x.dtype)
    s = sin[None, :, None, :].astype(x.dtype)
    return x * c + rot * s


def diff_attention(qa, ka, va, lam, lam_init, subln_g, rel_bias):
    B, S, _ = qa.shape
    nblk = S // Q_BLOCK
    scale = A_QK_DIM ** -0.5
    q = qa.reshape(B, nblk, Q_BLOCK, A_HEADS, 2, A_QK_DIM).transpose(1, 0, 2, 3, 4, 5)
    k = ka.reshape(B, S, A_HEADS, 2, A_QK_DIM)
    v = va.reshape(B, S, A_HEADS, A_V_DIM)
    kpos = jnp.arange(S, dtype=jnp.int32)

    def block(args):
        qb, start = args
        qpos = start + jnp.arange(Q_BLOCK, dtype=jnp.int32)
        bias = rel_bias[t5_bucket(kpos[None, :] - qpos[:, None])]
        bias = bias.transpose(2, 0, 1).astype(jnp.float32)
        s = jnp.einsum('bqhcd,bkhcd->cbhqk', qb, k).astype(jnp.float32) * scale + bias
        p = jax.nn.softmax(s, axis=-1)
        a = p[0] - lam * p[1]
        return jnp.einsum('bhqk,bkhe->bqhe', a.astype(v.dtype), v)

    starts = jnp.arange(nblk, dtype=jnp.int32) * Q_BLOCK
    o = lax.map(block, (q, starts))
    o = o.transpose(1, 0, 2, 3, 4).reshape(B, S, A_HEADS, A_V_DIM)
    o = rms_norm(o, subln_g) * (1.0 - lam_init)
    return o.reshape(B, S, A_V_W)


def axial_gqa(qb_, kb_, vb_, q_norm_g, k_norm_g):
    B, S, _ = qb_.shape
    nblk = S // Q_BLOCK
    scale = B_HEAD_DIM ** -0.5
    cos, sin = axial_rope_tables(S)
    q = apply_axial_rope(rms_norm(qb_.reshape(B, S, B_HEADS, B_HEAD_DIM), q_norm_g), cos, sin)
    k = apply_axial_rope(rms_norm(kb_.reshape(B, S, B_KV_HEADS, B_HEAD_DIM), k_norm_g), cos, sin)
    v = vb_.reshape(B, S, B_KV_HEADS, B_HEAD_DIM)
    q = q.reshape(B, nblk, Q_BLOCK, B_KV_HEADS, B_GROUP, B_HEAD_DIM).transpose(1, 0, 2, 3, 4, 5)

    def block(qblk):
        s = jnp.einsum('bqkgd,bskd->bkgqs', qblk, k).astype(jnp.float32) * scale
        p = jax.nn.softmax(s, axis=-1)
        return jnp.einsum('bkgqs,bskd->bqkgd', p.astype(v.dtype), v)

    o = lax.map(block, q)
    return o.transpose(1, 0, 2, 3, 4, 5).reshape(B, S, B_Q_W)


def encoder_layer(x, layer_idx, w_in, lambda_q1, lambda_k1, lambda_q2, lambda_k2, subln_g,
                  q_norm_g, k_norm_g, rel_bias, w_proj_a, w_proj_b, w_o, ln1_g, ln1_b,
                  w_gate, w_up, w_down, ln2_g, ln2_b):
    lam_init = 0.8 - 0.6 * math.exp(-0.3 * layer_idx)
    lam = (jnp.exp(jnp.sum(lambda_q1.astype(jnp.float32) * lambda_k1.astype(jnp.float32)))
           - jnp.exp(jnp.sum(lambda_q2.astype(jnp.float32) * lambda_k2.astype(jnp.float32)))
           + lam_init)
    proj = x @ w_in
    qa, ka, va, qb, kb, vb, ga, gb = jnp.split(proj, IN_SPLITS, axis=-1)
    oa = diff_attention(qa, ka, va, lam, lam_init, subln_g, rel_bias)
    ob = axial_gqa(qb, kb, vb, q_norm_g, k_norm_g)
    merged = jax.nn.sigmoid(ga) * (oa @ w_proj_a) + jax.nn.sigmoid(gb) * (ob @ w_proj_b)
    h = layer_norm(DEEPNORM_ALPHA * x + merged @ w_o, ln1_g, ln1_b)
    ffn = (jax.nn.silu(h @ w_gate) * (h @ w_up)) @ w_down
    return layer_norm(DEEPNORM_ALPHA * h + ffn, ln2_g, ln2_b)


def setup_inputs(seed: int = 0) -> dict:
    key = jax.random.key(seed)
    ks = jax.random.split(key, 32)
    f32 = jnp.float32

    def nrm(k, shape, scale):
        return jax.random.normal(k, shape, f32) * scale

    s_in = D_MODEL ** -0.5
    beta = DEEPNORM_BETA
    cols = [
        nrm(ks[2], (DEPTH, D_MODEL, A_Q_W), s_in),
        nrm(ks[3], (DEPTH, D_MODEL, A_K_W), s_in),
        nrm(ks[4], (DEPTH, D_MODEL, A_V_W), s_in * beta),
        nrm(ks[5], (DEPTH, D_MODEL, B_Q_W), s_in),
        nrm(ks[6], (DEPTH, D_MODEL, B_KV_W), s_in),
        nrm(ks[7], (DEPTH, D_MODEL, B_KV_W), s_in * beta),
        nrm(ks[8], (DEPTH, D_MODEL, GATE_W), s_in),
        nrm(ks[9], (DEPTH, D_MODEL, GATE_W), s_in),
    ]
    return {
        "x_prompt": jax.random.normal(ks[0], (BATCH, SEQ, D_MODEL), f32),
        "x_sample": jax.random.normal(ks[1], (DEC_BATCH, DEC_SEQ, D_MODEL), f32),
        "w_in": jnp.concatenate(cols, axis=-1),
        "lambda_q1": nrm(ks[10], (DEPTH, A_QK_DIM), 0.1),
        "lambda_k1": nrm(ks[11], (DEPTH, A_QK_DIM), 0.1),
        "lambda_q2": nrm(ks[12], (DEPTH, A_QK_DIM), 0.1),
        "lambda_k2": nrm(ks[13], (DEPTH, A_QK_DIM), 0.1),
        "subln_g": 1.0 + nrm(ks[14], (DEPTH, A_V_DIM), 0.02),
        "q_norm_g": 1.0 + nrm(ks[15], (DEPTH, B_HEAD_DIM), 0.02),
        "k_norm_g": 1.0 + nrm(ks[16], (DEPTH, B_HEAD_DIM), 0.02),
        "rel_bias": nrm(ks[17], (REL_BUCKETS, A_HEADS), 0.5),
        "w_proj_a": nrm(ks[18], (DEPTH, A_V_W, D_MODEL), A_V_W ** -0.5 * beta),
        "w_proj_b": nrm(ks[19], (DEPTH, B_Q_W, D_MODEL), B_Q_W ** -0.5 * beta),
        "w_o": nrm(ks[20], (DEPTH, D_MODEL, D_MODEL), s_in * beta),
        "ln1_g": 1.0 + nrm(ks[21], (DEPTH, D_MODEL), 0.02),
        "ln1_b": nrm(ks[22], (DEPTH, D_MODEL), 0.02),
        "w_gate": nrm(ks[23], (DEPTH, D_MODEL, D_FF), s_in),
        "w_up": nrm(ks[24], (DEPTH, D_MODEL, D_FF), s_in),
        "w_down": nrm(ks[25], (DEPTH, D_FF, D_MODEL), D_FF ** -0.5 * beta),
        "ln2_g": 1.0 + nrm(ks[26], (DEPTH, D_MODEL), 0.02),
        "ln2_b": nrm(ks[27], (DEPTH, D_MODEL), 0.02),
    }


def reference(x_prompt, x_sample, w_in, lambda_q1, lambda_k1, lambda_q2, lambda_k2, subln_g,
              q_norm_g, k_norm_g, rel_bias, w_proj_a, w_proj_b, w_o, ln1_g, ln1_b,
              w_gate, w_up, w_down, ln2_g, ln2_b):
    def run(x):
        for l in range(DEPTH):
            x = encoder_layer(x, l, w_in[l], lambda_q1[l], lambda_k1[l], lambda_q2[l], lambda_k2[l],
                              subln_g[l], q_norm_g[l], k_norm_g[l], rel_bias, w_proj_a[l],
                              w_proj_b[l], w_o[l], ln1_g[l], ln1_b[l], w_gate[l], w_up[l],
                              w_down[l], ln2_g[l], ln2_b[l])
        return x

    y_prompt = run(x_prompt)
    y_sample = run(x_sample)
    return (y_prompt, y_sample)
```

```cpp
#include <hip/hip_runtime.h>
#include <hip/hip_cooperative_groups.h>
#include <cstdio>
#include <cstdint>
namespace cg = cooperative_groups;

#ifndef MK_N_LAUNCHES
#define MK_N_LAUNCHES 1
#endif

#define LAS __attribute__((address_space(3)))
typedef unsigned short bf16_t;
typedef short bf16x8 __attribute__((ext_vector_type(8)));
typedef short s16x4 __attribute__((ext_vector_type(4)));
typedef float f32x4 __attribute__((ext_vector_type(4)));
typedef float f32x2 __attribute__((ext_vector_type(2)));
typedef float f32x16 __attribute__((ext_vector_type(16)));
typedef unsigned u32x4 __attribute__((ext_vector_type(4)));
typedef unsigned u32x2 __attribute__((ext_vector_type(2)));

constexpr int DM = 1024, M_P = 2 * 8192, M_S = 32 * 2048, M = M_P + M_S;
constexpr int S_P = 8192, S_S = 2048;
constexpr int NQKV = 4608, NIN = 6656, DFF = 2816;
constexpr float ALPHA = 1.189207115002721f;
constexpr float LN_EPS = 1e-5f, RMS_EPS = 1e-6f;
constexpr float LAM_INIT = 0.2f;

constexpr size_t MiB = 1u << 20;
constexpr size_t WS_TBL_R = 4096, WS_TBL_C = 36864, WS_TBL_BIAS = 53248, WS_TBL_LAM = 61568;
constexpr size_t WS_WIN = 1 * MiB;
constexpr size_t WS_WA = 14 * MiB, WS_WB = 16 * MiB, WS_WO = 18 * MiB;
constexpr size_t WS_WGU = 20 * MiB;
constexpr size_t WS_WD = 31 * MiB;
constexpr size_t WS_XB = 37 * MiB;
constexpr size_t WS_QA = 197 * MiB, WS_KA = 357 * MiB, WS_VA = 517 * MiB, WS_QB = 677 * MiB;
constexpr size_t WS_KB = 837 * MiB, WS_VB = 877 * MiB;
constexpr size_t WS_END = 917 * MiB;
constexpr size_t WS_MG = WS_KA;
constexpr size_t WS_SCR = WS_VA;
constexpr size_t WS_HB = WS_VA;
constexpr size_t WS_ACT = WS_XB;

constexpr int LDS_BYTES = 147456;

typedef __bf16 bf16x2_t __attribute__((ext_vector_type(2)));
__device__ __forceinline__ unsigned cvt_pk_bf16(float lo, float hi) { f32x2 v = {lo, hi}; bf16x2_t b = __builtin_convertvector(v, bf16x2_t); return __builtin_bit_cast(unsigned, b); }
__device__ __forceinline__ unsigned f2bf(float f) { unsigned u = __builtin_bit_cast(unsigned, f); return (u + 0x7fffu + ((u >> 16) & 1u)) >> 16; }
__device__ __forceinline__ float bf2f(unsigned h) { return __builtin_bit_cast(float, h << 16); }
__device__ __forceinline__ float wave_sum(float v) {
#pragma unroll
    for (int o = 1; o < 64; o <<= 1) v += __shfl_xor(v, o);
    return v;
}

namespace pg8 {
constexpr int BM = 256, BK = 64, HALF = 128, HTB = HALF * BK * 2, STAGE_BYTES = 8 * HTB, NXCD = 8, WGM = 8;
__host__ __device__ __forceinline__ int lds_byte(int r, int c) { const int st = (r >> 4) * 2 + (c >> 5), rr = r & 15, cc = c & 31, ob = rr * 64 + cc * 2; return st * 1024 + (ob ^ (((ob >> 9) & 1) << 5)); }
__host__ __device__ __forceinline__ void stage_rc(int b, int& R, int& C) { const int st = b / 1024, sb = b % 1024, swz = sb ^ (((sb >> 9) & 1) << 5); R = (st >> 1) * 16 + swz / 64; C = (st & 1) * 32 + (swz % 64) / 2; }
__host__ __device__ __forceinline__ int perm32(int rho) { const int n = rho >> 4, i = rho & 15; return 8 * (i >> 2) + 4 * n + (i & 3); }

struct Unit { int pm, pn, sub; };

__device__ __forceinline__ void tile_of(int L, int nM, int nN, int nwg, Unit& u) {
    int wgid = L; { const int q = nwg / NXCD, r = nwg % NXCD, xcd = wgid % NXCD, off = wgid / NXCD; wgid = (xcd < r ? xcd * (q + 1) : r * (q + 1) + (xcd - r) * q) + off; }
    const int nig = WGM * nN, gid = wgid / nig, fm = gid * WGM, gsz = (nM - fm) < WGM ? (nM - fm) : WGM;
    u.pm = fm + ((wgid % nig) % gsz); u.pn = (wgid % nig) / gsz;
}
struct SchedG {
    int nM, nN, nwg, G, c; const char* A; const char* B;
    __device__ void init(int M_, int N_, int G_, int c_, const void* A_, const void* B_) { nM = M_ / BM; nN = N_ / BM; nwg = nM * nN; G = G_; c = c_; A = (const char*)A_; B = (const char*)B_; }
    __device__ __forceinline__ bool next(int i, Unit& u) const { const long L = (long)i * G + c; if (L >= nwg) return false; tile_of((int)L, nM, nN, nwg, u); u.sub = 0; return true; }
    __device__ __forceinline__ const char* abase(const Unit&) const { return A; }
    __device__ __forceinline__ const char* bbase(const Unit&) const { return B; }
};
struct SchedMerge {
    int nM, nN, nwg, G, c; const char* ws;
    __device__ __forceinline__ bool next(int i, Unit& u) const { const long L = (long)(i >> 2) * G + c; if (L >= nwg) return false; tile_of((int)L, nM, nN, nwg, u); u.sub = i & 3; return true; }
    __device__ __forceinline__ const char* abase(const Unit& u) const { const size_t off = u.sub < 2 ? WS_XB : (u.sub == 2 ? WS_QA : WS_QB); return ws + off; }
    __device__ __forceinline__ const char* bbase(const Unit& u) const {
        const size_t off = u.sub == 0 ? (WS_WIN + (size_t)4608 * 2048) : (u.sub == 1 ? (WS_WIN + (size_t)5632 * 2048) : (u.sub == 2 ? WS_WA : WS_WB)); return ws + off; }
};

struct EpiQKV {
    static constexpr bool PERM = true;
    bf16_t* q4; bf16_t* kb; bf16_t* vb;
    __device__ __forceinline__ void operator()(const f32x4 (&acc)[2][2][4][2], const Unit& u, int wr, int wc, int fr, int fq) const {
        bf16_t* base; int ldc, colt;
        if (u.pn < 16) { base = q4 + (size_t)(u.pn >> 2) * ((size_t)M * 1024); ldc = 1024; colt = (u.pn & 3) * 256; }
        else if (u.pn == 16) { base = kb; ldc = 256; colt = 0; } else { base = vb; ldc = 256; colt = 0; }
        const int row0 = u.pm * BM + wr * 64 + fr, col0 = colt + wc * 32 + 8 * fq;
#pragma unroll
        for (int ai = 0; ai < 2; ++ai)
#pragma unroll
            for (int m = 0; m < 4; ++m) { bf16_t* rowp = base + (size_t)(row0 + ai * HALF + m * 16) * ldc + col0;
#pragma unroll
                for (int bj = 0; bj < 2; ++bj) { const f32x4 v0 = acc[ai][bj][m][0], v1 = acc[ai][bj][m][1];
                    u32x4 w; w.x = cvt_pk_bf16(v0[0], v0[1]); w.y = cvt_pk_bf16(v0[2], v0[3]); w.z = cvt_pk_bf16(v1[0], v1[1]); w.w = cvt_pk_bf16(v1[2], v1[3]);
                    *(u32x4*)(rowp + bj * HALF) = w; } }
    }
};
__device__ __forceinline__ float sigmoidf_(float a) { return __builtin_amdgcn_rcpf(1.f + __builtin_amdgcn_exp2f(-1.4426950408889634f * a)); }
#define OPAQUE_V(x) asm volatile("" : "+v"(x))
struct EpiMerge {
    static constexpr bool PERM = true;
    unsigned char* s1; unsigned char* s3; bf16_t* mg;
    __device__ __forceinline__ void operator()(const f32x4 (&acc)[2][2][4][2], const Unit& u, int wr, int wc, int fr, int fq) const {
        const int sub = __builtin_amdgcn_readfirstlane(u.sub);
        unsigned tid = threadIdx.x; OPAQUE_V(tid);
        if (sub < 2) {
            unsigned char* sg = s1 + (sub ? 131072 : 0);
#pragma unroll
            for (int ai = 0; ai < 2; ++ai)
#pragma unroll
                for (int m = 0; m < 4; ++m) {
                    unsigned t2 = tid; OPAQUE_V(t2); unsigned char* p = sg + (ai * 8 + m * 2) * 8192 + t2 * 16u;
#pragma unroll
                    for (int bj = 0; bj < 2; ++bj) {
                        const f32x4 v0 = acc[ai][bj][m][0], v1 = acc[ai][bj][m][1];
                        u32x4 w; w.x = cvt_pk_bf16(sigmoidf_(v0[0]), sigmoidf_(v0[1])); w.y = cvt_pk_bf16(sigmoidf_(v0[2]), sigmoidf_(v0[3]));
                        w.z = cvt_pk_bf16(sigmoidf_(v1[0]), sigmoidf_(v1[1])); w.w = cvt_pk_bf16(sigmoidf_(v1[2]), sigmoidf_(v1[3]));
                        *(u32x4*)(p + bj * 8192) = w; } }
        } else if (sub == 2) {
#pragma unroll
            for (int ai = 0; ai < 2; ++ai)
#pragma unroll
                for (int m = 0; m < 4; ++m) {
                    unsigned t2 = tid; OPAQUE_V(t2); const unsigned char* p = s1 + (ai * 8 + m * 2) * 8192 + t2 * 16u; unsigned char* q = s3 + (ai * 8 + m * 2) * 16384 + t2 * 32u;
#pragma unroll
                    for (int bj = 0; bj < 2; ++bj) {
                        const f32x4 v0 = acc[ai][bj][m][0], v1 = acc[ai][bj][m][1];
                        const u32x4 g = *(const u32x4*)(p + bj * 8192);
                        const f32x4 g0 = {bf2f(g.x & 0xffffu), bf2f(g.x >> 16), bf2f(g.y & 0xffffu), bf2f(g.y >> 16)};
                        const f32x4 g1 = {bf2f(g.z & 0xffffu), bf2f(g.z >> 16), bf2f(g.w & 0xffffu), bf2f(g.w >> 16)};
                        *(f32x4*)(q + bj * 16384) = g0 * v0; *(f32x4*)(q + bj * 16384 + 16) = g1 * v1; }
                    asm volatile("" ::: "memory"); }
        } else {
            unsigned char* mgu = (unsigned char*)mg + (size_t)u.pm * (256 * 2048) + u.pn * 512;
#pragma unroll
            for (int ai = 0; ai < 2; ++ai)
#pragma unroll
                for (int m = 0; m < 4; ++m) {
                    unsigned t2 = tid; OPAQUE_V(t2); const unsigned char* p = s1 + 131072 + (ai * 8 + m * 2) * 8192 + t2 * 16u; const unsigned char* q = s3 + (ai * 8 + m * 2) * 16384 + t2 * 32u;
                    const unsigned lane_off = ((t2 >> 8) * 64 + (t2 & 15)) * 2048u + (((t2 >> 6) & 3) * 32 + 8 * ((t2 >> 4) & 3)) * 2u;
                    unsigned char* r = mgu + (ai * HALF + m * 16) * 2048 + lane_off;
#pragma unroll
                    for (int bj = 0; bj < 2; ++bj) {
                        const f32x4 v0 = acc[ai][bj][m][0], v1 = acc[ai][bj][m][1];
                        const u32x4 g = *(const u32x4*)(p + bj * 8192);
                        const f32x4 g0 = {bf2f(g.x & 0xffffu), bf2f(g.x >> 16), bf2f(g.y & 0xffffu), bf2f(g.y >> 16)};
                        const f32x4 g1 = {bf2f(g.z & 0xffffu), bf2f(g.z >> 16), bf2f(g.w & 0xffffu), bf2f(g.w >> 16)};
                        const f32x4 t0 = g0 * v0 + *(const f32x4*)(q + bj * 16384), t1 = g1 * v1 + *(const f32x4*)(q + bj * 16384 + 16);
                        u32x4 w; w.x = cvt_pk_bf16(t0[0], t0[1]); w.y = cvt_pk_bf16(t0[2], t0[3]); w.z = cvt_pk_bf16(t1[0], t1[1]); w.w = cvt_pk_bf16(t1[2], t1[3]);
                        *(u32x4*)(r + bj * 256) = w; }
                    asm volatile("" ::: "memory"); }
        }
    }
};
struct EpiWo {
    static constexpr bool PERM = false;
    const float* xp; const float* xs; float* out;
    __device__ __forceinline__ void operator()(const f32x4 (&acc)[2][2][4][2], const Unit& u, int wr, int wc, int fr, int fq) const {
        const int row0 = u.pm * BM + wr * 64 + fr, col0 = u.pn * BM + wc * 32 + 4 * fq;
        const float* xb = (row0 < M_P) ? xp : (xs - (size_t)M_P * 1024);
#pragma unroll
        for (int ai = 0; ai < 2; ++ai)
#pragma unroll
            for (int m = 0; m < 4; ++m) { const size_t off = (size_t)(row0 + ai * HALF + m * 16) * 1024 + col0;
#pragma unroll
                for (int bj = 0; bj < 2; ++bj)
#pragma unroll
                    for (int n = 0; n < 2; ++n) { const f32x4 xv = *(const f32x4*)(xb + off + bj * HALF + n * 16);
                        *(f32x4*)(out + off + bj * HALF + n * 16) = xv * ALPHA + acc[ai][bj][m][n]; } }
    }
};
struct EpiGU {
    static constexpr bool PERM = true;
    bf16_t* act;
    __device__ __forceinline__ void operator()(const f32x4 (&acc)[2][2][4][2], const Unit& u, int wr, int wc, int fr, int fq) const {
        const int row0 = u.pm * BM + wr * 64 + fr, col0 = u.pn * HALF + wc * 32 + 8 * fq;
#pragma unroll
        for (int ai = 0; ai < 2; ++ai)
#pragma unroll
            for (int m = 0; m < 4; ++m) {
                f32x4 r0, r1;
#pragma unroll
                for (int j = 0; j < 4; ++j) { const float g0 = acc[ai][0][m][0][j], g1 = acc[ai][0][m][1][j];
                    r0[j] = g0 * sigmoidf_(g0) * acc[ai][1][m][0][j]; r1[j] = g1 * sigmoidf_(g1) * acc[ai][1][m][1][j]; }
                u32x4 w; w.x = cvt_pk_bf16(r0[0], r0[1]); w.y = cvt_pk_bf16(r0[2], r0[3]); w.z = cvt_pk_bf16(r1[0], r1[1]); w.w = cvt_pk_bf16(r1[2], r1[3]);
                *(u32x4*)(act + (size_t)(row0 + ai * HALF + m * 16) * DFF + col0) = w; }
    }
};
struct EpiDown {
    static constexpr bool PERM = false;
    float* out;
    __device__ __forceinline__ void operator()(const f32x4 (&acc)[2][2][4][2], const Unit& u, int wr, int wc, int fr, int fq) const {
        const int row0 = u.pm * BM + wr * 64 + fr, col0 = u.pn * BM + wc * 32 + 4 * fq;
#pragma unroll
        for (int ai = 0; ai < 2; ++ai)
#pragma unroll
            for (int m = 0; m < 4; ++m) { const size_t off = (size_t)(row0 + ai * HALF + m * 16) * 1024 + col0;
#pragma unroll
                for (int bj = 0; bj < 2; ++bj)
#pragma unroll
                    for (int n = 0; n < 2; ++n) { float* p = out + off + bj * HALF + n * 16; const f32x4 hv = *(const f32x4*)p;
                        *(f32x4*)p = hv * ALPHA + acc[ai][bj][m][n]; } }
    }
};

template <class Epi, class Sched>
__device__ __forceinline__ void gemm_phase(LAS unsigned char* lds, const int K, const Sched& S, const Epi& E) {
    int tid_ = threadIdx.x; asm volatile("" : "+v"(tid_));
    const int tid = tid_, wid = __builtin_amdgcn_readfirstlane(tid >> 6), lane = tid & 63, wr = wid >> 2, wc = wid & 3, fr = lane & 15, fq = lane >> 4;
    const int nt = K / BK;
    unsigned voffA[2], voffB[2];
#pragma unroll
    for (int i = 0; i < 2; ++i) { int R, C; stage_rc(tid * 16 + i * 8192, R, C); const int Rb = Epi::PERM ? ((R & ~31) + perm32(R & 31)) : R;
        voffA[i] = (unsigned)(R * K + C) * 2u; voffB[i] = (unsigned)(Rb * K + C) * 2u; }
    const size_t kstep = (size_t)(BK * 2);
    const size_t hstep = (size_t)HALF * K * 2;
    const size_t tstep = 2 * hstep;
    const unsigned ldsw = (unsigned)wid * 1024u;
    const int aoff = lds_byte(wr * 64 + fr, fq * 8), boff = lds_byte(wc * 32 + fr, fq * 8);
#define PG8_SA(b, h) (((b) * 2 + (h)) * HTB)
#define PG8_SB(b, h) ((4 + (b) * 2 + (h)) * HTB)
#define PG8_STAGE(bufoff, gbase, voff) do { _Pragma("unroll") for (int _i = 0; _i < 2; ++_i) \
        __builtin_amdgcn_global_load_lds((const unsigned*)((const char*)(gbase) + (voff)[_i]), (LAS unsigned*)(lds + (bufoff) + ldsw + _i * 8192), 16, 0, 0); } while (0)
#define PG8_LDA(dst, b, h) do { _Pragma("unroll") for (int m = 0; m < 4; ++m) _Pragma("unroll") for (int k = 0; k < 2; ++k) dst[m][k] = *(const LAS bf16x8*)(lds + PG8_SA(b, h) + aoff + m * 2048 + k * 1024); } while (0)
#define PG8_LDB(dst, b, h) do { _Pragma("unroll") for (int n = 0; n < 2; ++n) _Pragma("unroll") for (int k = 0; k < 2; ++k) dst[n][k] = *(const LAS bf16x8*)(lds + PG8_SB(b, h) + boff + n * 2048 + k * 1024); } while (0)
#define PG8_MMA(ai, bj, At, Bt) do { __builtin_amdgcn_s_setprio(1); _Pragma("unroll") for (int m = 0; m < 4; ++m) _Pragma("unroll") for (int n = 0; n < 2; ++n) _Pragma("unroll") for (int k = 0; k < 2; ++k) \
        acc[ai][bj][m][n] = __builtin_amdgcn_mfma_f32_16x16x32_bf16(Bt[n][k], At[m][k], acc[ai][bj][m][n], 0, 0, 0); __builtin_amdgcn_s_setprio(0); } while (0)
#define PG8_WAIT_V(n) asm volatile("s_waitcnt vmcnt(" #n ")" ::: "memory")
#define PG8_WAIT_L(n) asm volatile("s_waitcnt lgkmcnt(" #n ")" ::: "memory")
#define PG8_BAR __builtin_amdgcn_s_barrier()
#define PG8_SCHED __builtin_amdgcn_sched_barrier(0)
    Unit cur, nxt; int ui = 0;
    if (!S.next(0, cur)) return;
    f32x4 acc[2][2][4][2];
#pragma unroll
    for (int a = 0; a < 2; ++a)
#pragma unroll
        for (int b = 0; b < 2; ++b)
#pragma unroll
            for (int m = 0; m < 4; ++m)
#pragma unroll
                for (int n = 0; n < 2; ++n) acc[a][b][m][n] = (f32x4){0.f, 0.f, 0.f, 0.f};
    bf16x8 At[4][2], B0[2][2], B1[2][2];
    const char* cA = S.abase(cur) + (size_t)cur.pm * tstep; const char* cB = S.bbase(cur) + (size_t)cur.pn * tstep;
    PG8_STAGE(PG8_SB(0, 0), cB, voffB); PG8_STAGE(PG8_SB(0, 1), cB + hstep, voffB); PG8_STAGE(PG8_SA(0, 0), cA, voffA); PG8_STAGE(PG8_SA(0, 1), cA + hstep, voffA);
    if (wr == 1) PG8_BAR;
    PG8_WAIT_V(2); PG8_BAR;
    PG8_STAGE(PG8_SB(1, 0), cB + kstep, voffB); PG8_STAGE(PG8_SA(1, 0), cA + kstep, voffA); PG8_STAGE(PG8_SB(1, 1), cB + hstep + kstep, voffB);
    PG8_WAIT_V(6); PG8_BAR;
    for (;;) {
        const bool has_next = S.next(ui + 1, nxt);
        const char* nA = has_next ? S.abase(nxt) + (size_t)nxt.pm * tstep : cA; const char* nB = has_next ? S.bbase(nxt) + (size_t)nxt.pn * tstep : cB;
        for (int t = 0; t < nt; t += 2) {
            const bool last = (t == nt - 2);
            const char* a1 = cA + (size_t)(t + 1) * kstep;
            const char* a2 = last ? nA : cA + (size_t)(t + 2) * kstep; const char* b2 = last ? nB : cB + (size_t)(t + 2) * kstep;
            const char* a3 = a2 + kstep; const char* b3 = b2 + kstep;
            PG8_LDB(B0, 0, 0); PG8_LDB(B1, 0, 1); PG8_SCHED; PG8_LDA(At, 0, 0); PG8_STAGE(PG8_SA(1, 1), a1 + hstep, voffA);
            PG8_WAIT_V(8); PG8_WAIT_L(0); PG8_BAR; PG8_MMA(0, 0, At, B0); PG8_MMA(0, 1, At, B1); PG8_BAR; PG8_SCHED;
            PG8_LDA(At, 0, 1); PG8_STAGE(PG8_SB(0, 0), b2, voffB); PG8_STAGE(PG8_SB(0, 1), b2 + hstep, voffB); PG8_STAGE(PG8_SA(0, 0), a2, voffA);
            PG8_WAIT_V(8); PG8_WAIT_L(0); PG8_BAR; PG8_MMA(1, 0, At, B0); PG8_MMA(1, 1, At, B1); PG8_BAR; PG8_SCHED;
            PG8_LDB(B0, 1, 0); PG8_LDB(B1, 1, 1); PG8_SCHED; PG8_LDA(At, 1, 0); PG8_STAGE(PG8_SA(0, 1), a2 + hstep, voffA);
            PG8_WAIT_V(8); PG8_WAIT_L(0); PG8_BAR; PG8_MMA(0, 0, At, B0); PG8_MMA(0, 1, At, B1); PG8_BAR; PG8_SCHED;
            PG8_LDA(At, 1, 1); PG8_STAGE(PG8_SB(1, 0), b3, voffB); PG8_STAGE(PG8_SB(1, 1), b3 + hstep, voffB); PG8_STAGE(PG8_SA(1, 0), a3, voffA);
            PG8_WAIT_V(8); PG8_WAIT_L(0); PG8_BAR; PG8_MMA(1, 0, At, B0); PG8_MMA(1, 1, At, B1); PG8_BAR; PG8_SCHED;
        }
        if (wr == 0) PG8_BAR;
        E(acc, cur, wr, wc, fr, fq);
        if (!has_next) break;
#pragma unroll
        for (int a = 0; a < 2; ++a)
#pragma unroll
            for (int b = 0; b < 2; ++b)
#pragma unroll
                for (int m = 0; m < 4; ++m)
#pragma unroll
                    for (int n = 0; n < 2; ++n) acc[a][b][m][n] = (f32x4){0.f, 0.f, 0.f, 0.f};
        cur = nxt; cA = nA; cB = nB; ++ui;
        if (wr == 1) PG8_BAR;
    }
    PG8_WAIT_V(0);
    PG8_BAR;
#undef PG8_SA
#undef PG8_SB
#undef PG8_STAGE
#undef PG8_LDA
#undef PG8_LDB
#undef PG8_MMA
#undef PG8_WAIT_V
#undef PG8_WAIT_L
#undef PG8_BAR
#undef PG8_SCHED
}
}

namespace att {
constexpr int NW = 8, KVBLK = 64;
constexpr int SHM_V = KVBLK * 128 * 2, SHM_K = KVBLK * 128 * 2;
constexpr int LDS_WS = 2 * SHM_V + 2 * SHM_K, LDS_BT = LDS_WS + NW * 64 * 4, LDS_ATT = LDS_BT + 260 * 4;
constexpr float THR = 8.f;
#define KSWZ(row, colB) ((row) * 256 + ((colB) ^ (((row) & 7) << 4)))
#define SBAR() __builtin_amdgcn_sched_barrier(0)
__device__ __forceinline__ int crow(int r, int hi) { return (r & 3) + 8 * (r >> 2) + 4 * hi; }
__device__ __forceinline__ unsigned cvtpk(float lo, float hi) { return cvt_pk_bf16(lo, hi); }

template <bool DIFF>
__device__ __forceinline__ void partialSM(f32x16& p0, f32x16& p1, float& m_reg, float& mn, float& alpha, const float cst) {
    constexpr float SCALE = DIFF ? 0.125f : 0.088388347648318440f;
    constexpr float C = SCALE * 1.4426950408889634f;
    float pmax = p0[0];
#pragma unroll
    for (int r = 1; r < 16; ++r) pmax = fmaxf(pmax, p0[r]);
#pragma unroll
    for (int r = 0; r < 16; ++r) pmax = fmaxf(pmax, p1[r]);
    { auto rr = __builtin_amdgcn_permlane32_swap(__float_as_uint(pmax), __float_as_uint(pmax), false, false);
      pmax = fmaxf(__uint_as_float(rr[0]), __uint_as_float(rr[1])); }
    pmax += cst;
    if (__builtin_expect(__all(pmax - m_reg <= THR / SCALE), 1)) { mn = m_reg; alpha = 1.f; }
    else { mn = fmaxf(m_reg, pmax); alpha = __builtin_amdgcn_exp2f((m_reg - mn) * C); m_reg = mn; }
    const float mnC = (cst - mn) * C;
#pragma unroll
    for (int r = 0; r < 16; ++r) p0[r] = fmaf(p0[r], C, mnC);
#pragma unroll
    for (int r = 0; r < 16; ++r) p1[r] = fmaf(p1[r], C, mnC);
#pragma unroll
    for (int r = 0; r < 16; ++r) p0[r] = __builtin_amdgcn_exp2f(p0[r]);
}
__device__ __forceinline__ void finishSM(f32x16& p0, f32x16& p1, float alpha, float& l_reg, bf16x8& pa0, bf16x8& pa1, bf16x8& pa2, bf16x8& pa3) {
#pragma unroll
    for (int r = 0; r < 16; ++r) p1[r] = __builtin_amdgcn_exp2f(p1[r]);
    float ps = 0;
#pragma unroll
    for (int r = 0; r < 16; ++r) ps += p0[r];
#pragma unroll
    for (int r = 0; r < 16; ++r) ps += p1[r];
    { auto rr = __builtin_amdgcn_permlane32_swap(__float_as_uint(ps), __float_as_uint(ps), false, false);
      ps = __uint_as_float(rr[0]) + __uint_as_float(rr[1]); }
    l_reg = l_reg * alpha + ps;
#define PK4(P, BASE, OUT) do { unsigned a0 = cvtpk(P[BASE + 0], P[BASE + 1]), a1 = cvtpk(P[BASE + 2], P[BASE + 3]);   \
    unsigned b0 = cvtpk(P[BASE + 4], P[BASE + 5]), b1 = cvtpk(P[BASE + 6], P[BASE + 7]);                              \
    auto r0 = __builtin_amdgcn_permlane32_swap(a0, b0, false, false); auto r1 = __builtin_amdgcn_permlane32_swap(a1, b1, false, false); \
    u32x4 w = {r0[0], r1[0], r0[1], r1[1]}; OUT = *reinterpret_cast<bf16x8*>(&w); } while (0)
    PK4(p0, 0, pa0); PK4(p0, 8, pa1); PK4(p1, 0, pa2); PK4(p1, 8, pa3);
#undef PK4
}
template <bool DIFF>
__device__ __forceinline__ void qkt(f32x16& p0, f32x16& p1, const bf16_t* Ks, const bf16x8* qr, int r32, int hi, int cofs) {
    p0 = f32x16{}; p1 = f32x16{};
#pragma unroll
    for (int d0 = 0; d0 < (DIFF ? 4 : 8); ++d0) { const int cb = (cofs + d0 * 16 + hi * 8) * 2;
        bf16x8 b0 = *reinterpret_cast<const bf16x8*>((const char*)Ks + KSWZ(r32, cb));
        bf16x8 b1 = *reinterpret_cast<const bf16x8*>((const char*)Ks + KSWZ(32 + r32, cb));
        p0 = __builtin_amdgcn_mfma_f32_32x32x16_bf16(b0, qr[d0], p0, 0, 0, 0);
        p1 = __builtin_amdgcn_mfma_f32_32x32x16_bf16(b1, qr[d0], p1, 0, 0, 0); }
}
__device__ __forceinline__ int v_st(int k, int c) { const int kk = (k & ~0xC) | ((k & 4) << 1) | ((k & 8) >> 1); return ((kk >> 3) * 4 + (c >> 5)) * 512 + ((kk & 7) * 32 + (c & 31)) * 2; }
__device__ __forceinline__ int v_rd_base(int lane) { return ((lane & 3) << 3) | (((lane >> 2) & 3) << 6) | (((lane >> 4) & 1) << 5) | (((lane >> 5) & 1) << 8); }
constexpr int v_rd_off(int d0, int ks, int half) { return d0 * 512 + ks * 4096 + half * 2048; }
template <int OFF> __device__ __forceinline__ s16x4 tr_read(int vb) {
    s16x4 r; asm volatile("ds_read_b64_tr_b16 %0, %1 offset:%2" : "=&v"(r) : "v"(vb), "i"(OFF) : "memory"); return r;
}
template <int D0> __device__ __forceinline__ void pv_one(f32x16& od, int vb, bf16x8 pa0, bf16x8 pa1, bf16x8 pa2, bf16x8 pa3) {
    const s16x4 l0 = tr_read<v_rd_off(D0, 0, 0)>(vb), h0 = tr_read<v_rd_off(D0, 0, 1)>(vb), l1 = tr_read<v_rd_off(D0, 1, 0)>(vb), h1 = tr_read<v_rd_off(D0, 1, 1)>(vb);
    const s16x4 l2 = tr_read<v_rd_off(D0, 2, 0)>(vb), h2 = tr_read<v_rd_off(D0, 2, 1)>(vb), l3 = tr_read<v_rd_off(D0, 3, 0)>(vb), h3 = tr_read<v_rd_off(D0, 3, 1)>(vb);
    asm volatile("s_waitcnt lgkmcnt(0)" ::: "memory"); SBAR();
#define PK(L, H) (bf16x8){L[0], L[1], L[2], L[3], H[0], H[1], H[2], H[3]}
    od = __builtin_amdgcn_mfma_f32_32x32x16_bf16(pa0, PK(l0, h0), od, 0, 0, 0);
    od = __builtin_amdgcn_mfma_f32_32x32x16_bf16(pa1, PK(l1, h1), od, 0, 0, 0);
    od = __builtin_amdgcn_mfma_f32_32x32x16_bf16(pa2, PK(l2, h2), od, 0, 0, 0);
    od = __builtin_amdgcn_mfma_f32_32x32x16_bf16(pa3, PK(l3, h3), od, 0, 0, 0);
#undef PK
}
__device__ __forceinline__ void pv_d0(f32x16* o, int vb, bf16x8 pa0, bf16x8 pa1, bf16x8 pa2, bf16x8 pa3) {
    pv_one<0>(o[0], vb, pa0, pa1, pa2, pa3); pv_one<1>(o[1], vb, pa0, pa1, pa2, pa3); pv_one<2>(o[2], vb, pa0, pa1, pa2, pa3); pv_one<3>(o[3], vb, pa0, pa1, pa2, pa3);
}

template <bool DIFF>
__device__ __forceinline__ void attn_unit(const bf16_t* __restrict__ Qb, const bf16_t* __restrict__ Kh, const bf16_t* __restrict__ Vh, bf16_t* __restrict__ Ob,
                                          const int seq, const int qpos0, char* lds,
                                          const float* __restrict__ btab_g, const float* __restrict__ lamp, const float* __restrict__ subg) {
    int tid_ = threadIdx.x; asm volatile("" : "+v"(tid_));
    const int tid = tid_, wid = __builtin_amdgcn_readfirstlane(tid >> 6), lane = tid & 63, r32 = lane & 31, hi = lane >> 5;
    constexpr int ldq = 1024, ldk = DIFF ? 1024 : 256;
    bf16_t* V_lds = (bf16_t*)lds; bf16_t* K_lds = (bf16_t*)(lds + 2 * SHM_V);
    float* wsp = (float*)(lds + LDS_WS) + wid * 64; float* li_l = wsp; float* al_l = wsp + 32;
    float* btab = (float*)(lds + LDS_BT);
    const int cmap = DIFF ? (wid >> 2) : 0;
    const int wrow = DIFF ? ((wid & 3) * 32) : (wid * 32);
    const int qw = qpos0 + wrow;
    float cL = 0.f, cR = 0.f;
    if constexpr (DIFF) { cL = __uint_as_float(__builtin_amdgcn_readfirstlane(__float_as_uint(btab_g[0]))); cR = __uint_as_float(__builtin_amdgcn_readfirstlane(__float_as_uint(btab_g[256]))); }
    __syncthreads();
    if (DIFF) { for (int i = tid; i < 257; i += 512) btab[i] = btab_g[i]; }
    float m_reg = -1e30f, l_reg = 0; f32x16 o[4] = {}; bf16x8 qr[DIFF ? 4 : 8];
    const bf16_t* Qw = Qb + (long)(wrow + r32) * ldq + cmap * 64 + hi * 8;
#pragma unroll
    for (int d0 = 0; d0 < (DIFF ? 4 : 8); ++d0) qr[d0] = *reinterpret_cast<const bf16x8*>(Qw + d0 * 16);
    const int sr = tid >> 4, sc = (tid & 15) * 8, vst0 = v_st(sr, sc), vst1 = v_st(32 + sr, sc);
    const int vb0 = (int)(uintptr_t)V_lds + v_rd_base(lane);
    struct { bf16x8 vs0, vs1, ks0, ks1; } sr_[2];
#define SLOAD(i, k0) do { sr_[i].vs0 = *(const bf16x8*)(&Vh[(long)((k0) + sr) * ldk + sc]); sr_[i].vs1 = *(const bf16x8*)(&Vh[(long)((k0) + 32 + sr) * ldk + sc]); \
    sr_[i].ks0 = *(const bf16x8*)(&Kh[(long)((k0) + sr) * ldk + sc]); sr_[i].ks1 = *(const bf16x8*)(&Kh[(long)((k0) + 32 + sr) * ldk + sc]); } while (0)
#define SWRITE(b, i) do { *(bf16x8*)((char*)V_lds + (b) * SHM_V + vst0) = sr_[i].vs0;          \
    *(bf16x8*)((char*)V_lds + (b) * SHM_V + vst1) = sr_[i].vs1; const int kc = sc * 2;               \
    *(bf16x8*)((char*)K_lds + (b) * SHM_K + KSWZ(sr, kc)) = sr_[i].ks0;                       \
    *(bf16x8*)((char*)K_lds + (b) * SHM_K + KSWZ(32 + sr, kc)) = sr_[i].ks1; } while (0)
#define SWAIT() asm volatile("s_waitcnt vmcnt(4)" ::: "memory")
#define RESC(a) do { if (__any((a) < 1.f)) { if (hi == 0) al_l[r32] = (a); asm volatile("s_waitcnt lgkmcnt(0)" ::: "memory"); \
    _Pragma("unroll") for (int d = 0; d < 4; ++d) _Pragma("unroll") for (int r = 0; r < 16; ++r) o[d][r] *= al_l[crow(r, hi)]; } } while (0)
#define BIAS(P0, P1, K0, CST) do { if constexpr (DIFF) { const int kq = (K0) - qw; if (kq > -191 && kq < 159) { CST = 0.f; const int bb = kq - r32 + 4 * hi + 128; \
    _Pragma("unroll") for (int r = 0; r < 16; ++r) { const int off = (r & 3) + 8 * (r >> 2); const int i0 = min(max(bb + off, 0), 256), i1 = min(max(bb + off + 32, 0), 256); \
        P0[r] += btab[i0]; P1[r] += btab[i1]; } } else CST = kq < 0 ? cL : cR; } else CST = 0.f; } while (0)
    f32x16 pA0, pA1, pB0, pB1; float mnA, mnB, alA, alB, cstA, cstB; bf16x8 pa0, pa1, pa2, pa3; const int NT = seq / KVBLK;
    constexpr int SE = 0, SO = 1;
    const int cofs = cmap * 64;
    SLOAD(SE, 0); asm volatile("s_waitcnt vmcnt(0)" ::: "memory"); SWRITE(0, SE); __syncthreads();
    qkt<DIFF>(pA0, pA1, K_lds, qr, r32, hi, cofs); BIAS(pA0, pA1, 0, cstA); partialSM<DIFF>(pA0, pA1, m_reg, mnA, alA, cstA);
    SLOAD(SO, KVBLK); if (2 < NT) SLOAD(SE, 2 * KVBLK);
    SWAIT(); SWRITE(1, SO); __syncthreads();
    for (int j = 1; j + 1 < NT; j += 2) {
        SBAR(); qkt<DIFF>(pB0, pB1, (bf16_t*)((char*)K_lds + SHM_K), qr, r32, hi, cofs);
        finishSM(pA0, pA1, alA, l_reg, pa0, pa1, pa2, pa3); SBAR();
        SLOAD(SO, (j + 2) * KVBLK); SBAR();
        pv_d0(o, vb0, pa0, pa1, pa2, pa3); BIAS(pB0, pB1, j * KVBLK, cstB); partialSM<DIFF>(pB0, pB1, m_reg, mnB, alB, cstB);
        __syncthreads(); SWAIT(); SWRITE(0, SE);
        RESC(alB); __syncthreads();
        SBAR(); qkt<DIFF>(pA0, pA1, K_lds, qr, r32, hi, cofs);
        finishSM(pB0, pB1, alB, l_reg, pa0, pa1, pa2, pa3); SBAR();
        if (j + 3 < NT) SLOAD(SE, (j + 3) * KVBLK); SBAR();
        pv_d0(o, vb0 + SHM_V, pa0, pa1, pa2, pa3); BIAS(pA0, pA1, (j + 1) * KVBLK, cstA); partialSM<DIFF>(pA0, pA1, m_reg, mnA, alA, cstA);
        __syncthreads(); SWAIT(); SWRITE(1, SO);
        RESC(alA); __syncthreads();
    }
    SBAR(); qkt<DIFF>(pB0, pB1, (bf16_t*)((char*)K_lds + SHM_K), qr, r32, hi, cofs);
    finishSM(pA0, pA1, alA, l_reg, pa0, pa1, pa2, pa3); SBAR();
    pv_d0(o, vb0, pa0, pa1, pa2, pa3); BIAS(pB0, pB1, (NT - 1) * KVBLK, cstB); partialSM<DIFF>(pB0, pB1, m_reg, mnB, alB, cstB);
    __syncthreads(); RESC(alB);
    finishSM(pB0, pB1, alB, l_reg, pa0, pa1, pa2, pa3); SBAR();
    pv_d0(o, vb0 + SHM_V, pa0, pa1, pa2, pa3);
    if (hi == 0) li_l[r32] = l_reg; asm volatile("s_waitcnt lgkmcnt(0)" ::: "memory");
    float rli[16];
#pragma unroll
    for (int r = 0; r < 16; ++r) rli[r] = __builtin_amdgcn_rcpf(li_l[crow(r, hi)]);
    if constexpr (!DIFF) {
        bf16_t* Ow = Ob + (long)wrow * ldq;
#pragma unroll
        for (int r = 0; r < 16; ++r) { const int orow = crow(r, hi);
#pragma unroll
            for (int d0 = 0; d0 < 4; ++d0) Ow[(long)orow * ldq + d0 * 32 + r32] = (bf16_t)f2bf(o[d0][r] * rli[r]); }
    } else {
        __syncthreads();
        float* xch = (float*)lds;
        const float lam = __uint_as_float(__builtin_amdgcn_readfirstlane(__float_as_uint(lamp[0])));
        if (cmap == 1) {
#pragma unroll
            for (int r = 0; r < 16; ++r) { const int row = wrow + crow(r, hi);
#pragma unroll
                for (int d0 = 0; d0 < 4; ++d0) xch[row * 128 + d0 * 32 + r32] = o[d0][r] * rli[r] * lam; }
        }
        __syncthreads();
        if (cmap == 0) {
            float g[4];
#pragma unroll
            for (int d0 = 0; d0 < 4; ++d0) g[d0] = subg[d0 * 32 + r32] * (1.f - LAM_INIT);
#pragma unroll
            for (int r = 0; r < 16; ++r) { const int row = wrow + crow(r, hi); float v[4]; float ss = 0.f;
#pragma unroll
                for (int d0 = 0; d0 < 4; ++d0) { v[d0] = o[d0][r] * rli[r] - xch[row * 128 + d0 * 32 + r32]; ss += v[d0] * v[d0]; }
                ss += __shfl_xor(ss, 1); ss += __shfl_xor(ss, 2); ss += __shfl_xor(ss, 4); ss += __shfl_xor(ss, 8); ss += __shfl_xor(ss, 16);
                const float rs = __builtin_amdgcn_rsqf(ss * (1.f / 128.f) + RMS_EPS);
#pragma unroll
                for (int d0 = 0; d0 < 4; ++d0) Ob[(long)row * ldq + d0 * 32 + r32] = (bf16_t)f2bf(v[d0] * rs * g[d0]); }
        }
    }
#undef SLOAD
#undef SWRITE
#undef SWAIT
#undef RESC
#undef BIAS
}
}

__device__ __forceinline__ void p0_transpose_item(const float* W, int K, int N, bf16_t* WT, int dst_row0, LAS float* scr, int k0, int n0, int lane) {
#pragma unroll 8
    for (int i = 0; i < 32; ++i) { const int kk = 2 * i + (lane >> 5); scr[kk * 33 + (lane & 31)] = W[(size_t)(k0 + kk) * N + n0 + (lane & 31)]; }
    asm volatile("s_waitcnt lgkmcnt(0)" ::: "memory");
    const int c = lane & 7;
#pragma unroll
    for (int j = 0; j < 4; ++j) { const int n = (lane >> 3) + 8 * j; const LAS float* s = scr + (8 * c) * 33 + n;
        u32x4 o; o.x = cvt_pk_bf16(s[0 * 33], s[1 * 33]); o.y = cvt_pk_bf16(s[2 * 33], s[3 * 33]); o.z = cvt_pk_bf16(s[4 * 33], s[5 * 33]); o.w = cvt_pk_bf16(s[6 * 33], s[7 * 33]);
        *(u32x4*)(WT + (size_t)(dst_row0 + n) * K + k0 + 8 * c) = o; }
    asm volatile("s_waitcnt lgkmcnt(0)" ::: "memory");
}
__device__ __forceinline__ int t5_bucket_dev(int rel) {
    const int n = rel < 0 ? -rel : rel; int b;
    if (n < 8) b = n; else if (n < 12) b = 8; else if (n < 16) b = 9; else if (n < 23) b = 10; else if (n < 32) b = 11; else if (n < 46) b = 12; else if (n < 64) b = 13; else if (n < 91) b = 14; else b = 15;
    return b + (rel > 0 ? 16 : 0);
}

struct Args { const float* in[21]; float* out; unsigned char* ws; int ph_lo, ph_hi; };

__global__ void __launch_bounds__(512, 2) enc_fwd(Args args) {
    extern __shared__ __attribute__((aligned(16))) unsigned char lds[];
    const int tid = threadIdx.x, lane = tid & 63, wave = __builtin_amdgcn_readfirstlane(tid >> 6);
    const int G = gridDim.x, bx = blockIdx.x;
    unsigned char* ws = args.ws;
    const int lo = args.ph_lo, hi_ = args.ph_hi;
#ifndef PH_MASK
#define PH_MASK 0x3ff
#endif
#define IN(k) (((PH_MASK >> (k)) & 1) && lo <= (k) && (k) < hi_)
#define SEAM(k) do { if (lo <= (k) && (k) + 1 < hi_) { __threadfence(); cg::this_grid().sync(); } } while (0)
    const float* x_p = args.in[0]; const float* x_s = args.in[1];
    bf16_t* XB = (bf16_t*)(ws + WS_XB); bf16_t* QA = (bf16_t*)(ws + WS_QA); bf16_t* KA = (bf16_t*)(ws + WS_KA); bf16_t* VA = (bf16_t*)(ws + WS_VA);
    bf16_t* QB = (bf16_t*)(ws + WS_QB); bf16_t* KB = (bf16_t*)(ws + WS_KB); bf16_t* VB = (bf16_t*)(ws + WS_VB);
    bf16_t* WinT = (bf16_t*)(ws + WS_WIN); bf16_t* WaT = (bf16_t*)(ws + WS_WA); bf16_t* WbT = (bf16_t*)(ws + WS_WB); bf16_t* WoT = (bf16_t*)(ws + WS_WO);
    bf16_t* WguT = (bf16_t*)(ws + WS_WGU); bf16_t* WdT = (bf16_t*)(ws + WS_WD);
    f32x2* tabR = (f32x2*)(ws + WS_TBL_R); f32x2* tabC = (f32x2*)(ws + WS_TBL_C); float* tabB = (float*)(ws + WS_TBL_BIAS); float* tabL = (float*)(ws + WS_TBL_LAM);
    const int gw = bx * 8 + wave, NGW = G * 8;

    if (IN(0)) {
        LAS float* scr = (LAS float*)((LAS unsigned char*)lds + wave * 16384);
        constexpr int I0 = 16 * 208, I1 = 16 * 32, I4 = 16 * 88, I6 = 44 * 32;
        constexpr int NITEMS = I0 + 3 * I1 + 2 * I4 + I6;
        for (int it = gw; it < NITEMS; it += NGW) {
            int r = it;
            if (r < I0) { const int kb = r / 208, nb = r % 208; p0_transpose_item(args.in[2], 1024, NIN, WinT, nb * 32, scr, kb * 64, nb * 32, lane); continue; } r -= I0;
            if (r < I1) { const int kb = r / 32, nb = r % 32; p0_transpose_item(args.in[11], 1024, 1024, WaT, nb * 32, scr, kb * 64, nb * 32, lane); continue; } r -= I1;
            if (r < I1) { const int kb = r / 32, nb = r % 32; p0_transpose_item(args.in[12], 1024, 1024, WbT, nb * 32, scr, kb * 64, nb * 32, lane); continue; } r -= I1;
            if (r < I1) { const int kb = r / 32, nb = r % 32; p0_transpose_item(args.in[13], 1024, 1024, WoT, nb * 32, scr, kb * 64, nb * 32, lane); continue; } r -= I1;
            if (r < I4) { const int kb = r / 88, nb = r % 88, n0 = nb * 32; p0_transpose_item(args.in[16], 1024, DFF, WguT, (n0 >> 7) * 256 + (n0 & 127), scr, kb * 64, n0, lane); continue; } r -= I4;
            if (r < I4) { const int kb = r / 88, nb = r % 88, n0 = nb * 32; p0_transpose_item(args.in[17], 1024, DFF, WguT, (n0 >> 7) * 256 + 128 + (n0 & 127), scr, kb * 64, n0, lane); continue; } r -= I4;
            { const int kb = r / 32, nb = r % 32; p0_transpose_item(args.in[18], DFF, 1024, WdT, nb * 32, scr, kb * 64, nb * 32, lane); }
        }
        { const size_t n8 = (size_t)M * 1024 / 8, np8 = (size_t)M_P * 1024 / 8;
          for (size_t i = (size_t)bx * 512 + tid; i < n8; i += (size_t)G * 512) {
              const float* src = i < np8 ? x_p + i * 8 : x_s + (i - np8) * 8;
              const f32x4 a = *(const f32x4*)src, b = *(const f32x4*)(src + 4);
              u32x4 w; w.x = cvt_pk_bf16(a[0], a[1]); w.y = cvt_pk_bf16(a[2], a[3]); w.z = cvt_pk_bf16(b[0], b[1]); w.w = cvt_pk_bf16(b[2], b[3]);
              *(u32x4*)(XB + i * 8) = w; } }
        for (int i = bx * 512 + tid; i < 192 * 32; i += G * 512) {
            const int p = i >> 5, f = i & 31; const int pos = p < 128 ? p : p - 128;
            const float freq = __builtin_amdgcn_exp2f(-(float)(2 * f) * (13.287712379549449f / 64.f));
            double rev = (double)((float)pos * freq) * 0.15915494309189535; rev -= __builtin_rint(rev);
            const float cs = __builtin_amdgcn_cosf((float)rev), sn = __builtin_amdgcn_sinf((float)rev);
            if (p < 128) tabR[p * 32 + f] = (f32x2){cs, sn}; else tabC[(p - 128) * 32 + f] = (f32x2){cs, sn};
        }
        for (int i = bx * 512 + tid; i < 8 * 260; i += G * 512) { const int h = i / 260, e = i % 260;
            tabB[i] = e <= 256 ? args.in[10][t5_bucket_dev(e - 128) * 8 + h] * 8.f : 0.f; }
        if (bx == 0 && wave == 0) {
            const float a = wave_sum(args.in[3][lane] * args.in[4][lane]), b = wave_sum(args.in[5][lane] * args.in[6][lane]);
            if (lane == 0) tabL[0] = expf(a) - expf(b) + LAM_INIT;
        }
    }
    SEAM(0);

    if (IN(1)) {
        pg8::SchedG S; S.init(M, NQKV, G, bx, XB, WinT);
        pg8::EpiQKV E{QA, KB, VB};
        pg8::gemm_phase<pg8::EpiQKV, pg8::SchedG>((LAS unsigned char*)lds, 1024, S, E);
    }
    SEAM(1);

    if (IN(2)) {
        const int rr = lane >> 3, c = lane & 7;
        const int NIT = M * 10 / 8;
        for (int it = gw; it < NIT; it += NGW) {
            const int rowid = it * 8 + rr;
            bf16_t* p; const float* g; int m;
            if (rowid < M * 8) { m = rowid >> 3; p = QB + (size_t)m * 1024 + (rowid & 7) * 128; g = args.in[8]; }
            else { const int r2 = rowid - M * 8; m = r2 >> 1; p = KB + (size_t)m * 256 + (r2 & 1) * 128; g = args.in[9]; }
            const int t = m < M_P ? (m & (S_P - 1)) : ((m - M_P) & (S_S - 1));
            float v[4][4];
#pragma unroll
            for (int q = 0; q < 4; ++q) { const u32x2 w = *(const u32x2*)(p + q * 32 + c * 4);
                v[q][0] = bf2f(w.x & 0xffffu); v[q][1] = bf2f(w.x >> 16); v[q][2] = bf2f(w.y & 0xffffu); v[q][3] = bf2f(w.y >> 16); }
            float ss = 0.f;
#pragma unroll
            for (int q = 0; q < 4; ++q)
#pragma unroll
                for (int j = 0; j < 4; ++j) ss += v[q][j] * v[q][j];
            ss += __shfl_xor(ss, 1); ss += __shfl_xor(ss, 2); ss += __shfl_xor(ss, 4);
            const float rs = __builtin_amdgcn_rsqf(ss * (1.f / 128.f) + RMS_EPS);
#pragma unroll
            for (int q = 0; q < 4; ++q) { const f32x4 gv = *(const f32x4*)(g + q * 32 + c * 4);
#pragma unroll
                for (int j = 0; j < 4; ++j) v[q][j] *= rs * gv[j]; }
            const f32x2* tr = tabR + (t >> 6) * 32 + c * 4; const f32x2* tc = tabC + (t & 63) * 32 + c * 4;
            u32x2 o[4];
            float oa[4], ob[4], oc[4], od[4];
#pragma unroll
            for (int j = 0; j < 4; ++j) { const f32x2 a = tr[j], b = tc[j];
                oa[j] = v[0][j] * a.x - v[1][j] * a.y; ob[j] = v[1][j] * a.x + v[0][j] * a.y;
                oc[j] = v[2][j] * b.x - v[3][j] * b.y; od[j] = v[3][j] * b.x + v[2][j] * b.y; }
            o[0].x = cvt_pk_bf16(oa[0], oa[1]); o[0].y = cvt_pk_bf16(oa[2], oa[3]); o[1].x = cvt_pk_bf16(ob[0], ob[1]); o[1].y = cvt_pk_bf16(ob[2], ob[3]);
            o[2].x = cvt_pk_bf16(oc[0], oc[1]); o[2].y = cvt_pk_bf16(oc[2], oc[3]); o[3].x = cvt_pk_bf16(od[0], od[1]); o[3].y = cvt_pk_bf16(od[2], od[3]);
#pragma unroll
            for (int q = 0; q < 4; ++q) *(u32x2*)(p + q * 32 + c * 4) = o[q];
        }
    }
    SEAM(2);

    if (IN(3)) {
        for (int idx = bx; idx < 7680; idx += G) {
            int b, h, qb, seq; size_t m0; bool diff;
            if (idx < 512) { b = idx >> 8; h = (idx >> 5) & 7; qb = idx & 31; m0 = (size_t)b * S_P; seq = S_P; diff = false; }
            else if (idx < 1536) { const int i = idx - 512; b = i >> 9; h = (i >> 6) & 7; qb = i & 63; m0 = (size_t)b * S_P; seq = S_P; diff = true; }
            else if (idx < 3584) { const int i = idx - 1536; b = i >> 6; h = (i >> 3) & 7; qb = i & 7; m0 = (size_t)M_P + (size_t)b * S_S; seq = S_S; diff = false; }
            else { const int i = idx - 3584; b = i >> 7; h = (i >> 4) & 7; qb = i & 15; m0 = (size_t)M_P + (size_t)b * S_S; seq = S_S; diff = true; }
#ifndef NO_GQA
            if (!diff) { bf16_t* qp = QB + (m0 + (size_t)qb * 256) * 1024 + h * 128;
                att::attn_unit<false>(qp, KB + m0 * 256 + (h >> 2) * 128, VB + m0 * 256 + (h >> 2) * 128, qp, seq, 0, (char*)lds, nullptr, nullptr, nullptr); }
#endif
#ifndef NO_DIFF
            if (diff) { bf16_t* qp = QA + (m0 + (size_t)qb * 128) * 1024 + h * 128;
                att::attn_unit<true>(qp, KA + m0 * 1024 + h * 128, VA + m0 * 1024 + h * 128, qp, seq, qb * 128, (char*)lds, tabB + h * 260, tabL, args.in[7]); }
#endif
        }
        __syncthreads();
    }
    SEAM(3);

    if (IN(4)) {
        pg8::SchedMerge S{M / 256, 4, (M / 256) * 4, G, bx, (const char*)ws};
        unsigned char* scrp = ws + WS_SCR + (size_t)bx * 524288;
        pg8::EpiMerge E{scrp, scrp + 262144, (bf16_t*)(ws + WS_MG)};
        pg8::gemm_phase<pg8::EpiMerge, pg8::SchedMerge>((LAS unsigned char*)lds, 1024, S, E);
    }
    SEAM(4);

    if (IN(5)) {
        pg8::SchedG S; S.init(M, 1024, G, bx, ws + WS_MG, WoT);
        pg8::EpiWo E{x_p, x_s, args.out};
        pg8::gemm_phase<pg8::EpiWo, pg8::SchedG>((LAS unsigned char*)lds, 1024, S, E);
    }
    SEAM(5);

    if (IN(6)) {
        bf16_t* HB = (bf16_t*)(ws + WS_HB);
        const f32x4* gp = (const f32x4*)args.in[14] + lane; const f32x4* bp = (const f32x4*)args.in[15] + lane;
        for (int m = gw; m < M; m += NGW) {
            f32x4* xr = (f32x4*)(args.out + (size_t)m * 1024) + lane;
            f32x4 v[4]; float s = 0.f;
#pragma unroll
            for (int j = 0; j < 4; ++j) { v[j] = xr[64 * j]; s += (v[j].x + v[j].y) + (v[j].z + v[j].w); }
            const float mean = wave_sum(s) * (1.f / 1024.f); float s2 = 0.f;
#pragma unroll
            for (int j = 0; j < 4; ++j) { v[j] = v[j] - mean; s2 += (v[j].x * v[j].x + v[j].y * v[j].y) + (v[j].z * v[j].z + v[j].w * v[j].w); }
            const float rstd = 1.f / sqrtf(wave_sum(s2) * (1.f / 1024.f) + LN_EPS);
            u32x2* o8 = (u32x2*)(HB + (size_t)m * 1024) + lane;
#pragma unroll
            for (int j = 0; j < 4; ++j) { const f32x4 hv = v[j] * rstd * gp[64 * j] + bp[64 * j]; xr[64 * j] = hv;
                u32x2 w; w.x = cvt_pk_bf16(hv.x, hv.y); w.y = cvt_pk_bf16(hv.z, hv.w); o8[64 * j] = w; }
        }
    }
    SEAM(6);

    if (IN(7)) {
        pg8::SchedG S; S.init(M, 2 * DFF, G, bx, ws + WS_HB, WguT);
        pg8::EpiGU E{(bf16_t*)(ws + WS_ACT)};
        pg8::gemm_phase<pg8::EpiGU, pg8::SchedG>((LAS unsigned char*)lds, 1024, S, E);
    }
    SEAM(7);

    if (IN(8)) {
        pg8::SchedG S; S.init(M, 1024, G, bx, ws + WS_ACT, WdT);
        pg8::EpiDown E{args.out};
        pg8::gemm_phase<pg8::EpiDown, pg8::SchedG>((LAS unsigned char*)lds, DFF, S, E);
    }
    SEAM(8);

    if (IN(9)) {
        const f32x4* gp = (const f32x4*)args.in[19] + lane; const f32x4* bp = (const f32x4*)args.in[20] + lane;
        for (int m = gw; m < M; m += NGW) {
            f32x4* xr = (f32x4*)(args.out + (size_t)m * 1024) + lane;
            f32x4 v[4]; float s = 0.f;
#pragma unroll
            for (int j = 0; j < 4; ++j) { v[j] = xr[64 * j]; s += (v[j].x + v[j].y) + (v[j].z + v[j].w); }
            const float mean = wave_sum(s) * (1.f / 1024.f); float s2 = 0.f;
#pragma unroll
            for (int j = 0; j < 4; ++j) { v[j] = v[j] - mean; s2 += (v[j].x * v[j].x + v[j].y * v[j].y) + (v[j].z * v[j].z + v[j].w * v[j].w); }
            const float rstd = 1.f / sqrtf(wave_sum(s2) * (1.f / 1024.f) + LN_EPS);
#pragma unroll
            for (int j = 0; j < 4; ++j) xr[64 * j] = v[j] * rstd * gp[64 * j] + bp[64 * j];
        }
    }
#ifdef DUMP_SRC
    SEAM(9);
    if (IN(10)) {
        const bf16_t* src = (const bf16_t*)(ws + (size_t)DUMP_SRC);
        for (size_t i = (size_t)bx * 512 + tid; i < (size_t)M * 1024 / 4; i += (size_t)G * 512) {
            const u32x2 w = *(const u32x2*)(src + i * 4);
            *(f32x4*)(args.out + i * 4) = (f32x4){bf2f(w.x & 0xffffu), bf2f(w.x >> 16), bf2f(w.y & 0xffffu), bf2f(w.y >> 16)};
        }
    }
#endif
#undef IN
#undef SEAM
}

#ifdef DUMP_SRC
constexpr int NPHASE = 11;
#else
constexpr int NPHASE = 10;
#endif
extern "C" void kernel_launch(void* const* d_in, const int* in_sizes, int n_in, void* d_out, int out_size, void* d_ws, size_t ws_size, hipStream_t stream) {
    static int grid = 0;
    if (grid == 0) {
        if (n_in != 21 || in_sizes[0] != M_P * DM || in_sizes[1] != M_S * DM || out_size != M * DM || ws_size < WS_END) {
            fprintf(stderr, "kernel_launch: shape mismatch (n_in %d, in0 %d, in1 %d, out %d, ws %zu)\n", n_in, n_in > 0 ? in_sizes[0] : -1, n_in > 1 ? in_sizes[1] : -1, out_size, ws_size); grid = -1; return; }
        int dev = 0, cus = 0, per_cu = 0;
        hipGetDevice(&dev); hipDeviceGetAttribute(&cus, hipDeviceAttributeMultiprocessorCount, dev);
        if (hipFuncSetAttribute((const void*)enc_fwd, hipFuncAttributeMaxDynamicSharedMemorySize, LDS_BYTES) != hipSuccess) { fprintf(stderr, "kernel_launch: hipFuncSetAttribute failed\n"); grid = -1; return; }
        if (hipOccupancyMaxActiveBlocksPerMultiprocessor(&per_cu, (const void*)enc_fwd, 512, LDS_BYTES) != hipSuccess || per_cu < 1) { fprintf(stderr, "kernel_launch: occupancy query says %d\n", per_cu); per_cu = 1; }
        (void)hipGetLastError();
        grid = cus * 1;
    }
    if (grid < 0) return;
    Args a{};
    for (int i = 0; i < 21; ++i) a.in[i] = (const float*)d_in[i];
    a.out = (float*)d_out; a.ws = (unsigned char*)d_ws;
#if MK_N_LAUNCHES == 1
    a.ph_lo = 0; a.ph_hi = NPHASE;
    void* kargs[] = {&a};
    hipError_t e = hipLaunchCooperativeKernel((const void*)enc_fwd, dim3(grid), dim3(512), kargs, LDS_BYTES, stream);
    if (e != hipSuccess) fprintf(stderr, "kernel_launch: cooperative launch failed: %s (grid %d)\n", hipGetErrorString(e), grid);
#else
    for (int p = 0; p < NPHASE; ++p) { a.ph_lo = p; a.ph_hi = p + 1; hipLaunchKernelGGL(enc_fwd, dim3(grid), dim3(512), LDS_BYTES, stream, a); }
#endif
}
```

```cpp
#include <hip/hip_runtime.h>
#include <hip/hip_cooperative_groups.h>
#include <cstdio>
#include <cstdint>
namespace cg = cooperative_groups;

#ifndef MK_N_LAUNCHES
#define MK_N_LAUNCHES 1
#endif

#define LAS __attribute__((address_space(3)))
typedef unsigned short bf16_t;
typedef short bf16x8 __attribute__((ext_vector_type(8)));
typedef short s16x4 __attribute__((ext_vector_type(4)));
typedef float f32x4 __attribute__((ext_vector_type(4)));
typedef float f32x2 __attribute__((ext_vector_type(2)));
typedef float f32x16 __attribute__((ext_vector_type(16)));
typedef unsigned u32x4 __attribute__((ext_vector_type(4)));
typedef unsigned u32x2 __attribute__((ext_vector_type(2)));

constexpr int DM = 1024, M_P = 2 * 8192, M_S = 32 * 2048, M = M_P + M_S;
constexpr int S_P = 8192, S_S = 2048;
constexpr int NQKV = 4608, NIN = 6656, DFF = 2816;
constexpr float ALPHA = 1.189207115002721f;
constexpr float LN_EPS = 1e-5f, RMS_EPS = 1e-6f;
constexpr float LAM_INIT = 0.2f;

constexpr size_t MiB = 1u << 20;
constexpr size_t WS_TBL_R = 4096, WS_TBL_C = 36864, WS_TBL_BIAS = 53248, WS_TBL_LAM = 69632;
constexpr size_t WS_WIN = 1 * MiB;
constexpr size_t WS_WA = 14 * MiB, WS_WB = 16 * MiB, WS_WO = 18 * MiB;
constexpr size_t WS_WGU = 20 * MiB;
constexpr size_t WS_WD = 31 * MiB;
constexpr size_t WS_XB = 37 * MiB;
constexpr size_t WS_QA = 197 * MiB, WS_KA = 357 * MiB, WS_VA = 517 * MiB, WS_QB = 677 * MiB;
constexpr size_t WS_KB = 837 * MiB, WS_VB = 877 * MiB;
constexpr size_t WS_END = 917 * MiB;
constexpr size_t WS_MG = WS_KA;
constexpr size_t WS_SCR = WS_VA;
constexpr size_t WS_HB = WS_VA;
constexpr size_t WS_ACT = WS_XB;

constexpr int LDS_BYTES = 147456;

typedef __bf16 bf16x2_t __attribute__((ext_vector_type(2)));
__device__ __forceinline__ unsigned cvt_pk_bf16(float lo, float hi) { f32x2 v = {lo, hi}; bf16x2_t b = __builtin_convertvector(v, bf16x2_t); return __builtin_bit_cast(unsigned, b); }
__device__ __forceinline__ unsigned f2bf(float f) { unsigned u = __builtin_bit_cast(unsigned, f); return (u + 0x7fffu + ((u >> 16) & 1u)) >> 16; }
__device__ __forceinline__ float bf2f(unsigned h) { return __builtin_bit_cast(float, h << 16); }
__device__ __forceinline__ float wave_sum(float v) {
#pragma unroll
    for (int o = 1; o < 64; o <<= 1) v += __shfl_xor(v, o);
    return v;
}

namespace pg8 {
constexpr int BM = 256, BK = 64, HALF = 128, HTB = HALF * BK * 2, STAGE_BYTES = 8 * HTB, NXCD = 8, WGM = 8;
__host__ __device__ __forceinline__ int lds_byte(int r, int c) { const int st = (r >> 4) * 2 + (c >> 5), rr = r & 15, cc = c & 31, ob = rr * 64 + cc * 2; return st * 1024 + (ob ^ (((ob >> 9) & 1) << 5)); }
__host__ __device__ __forceinline__ void stage_rc(int b, int& R, int& C) { const int st = b / 1024, sb = b % 1024, swz = sb ^ (((sb >> 9) & 1) << 5); R = (st >> 1) * 16 + swz / 64; C = (st & 1) * 32 + (swz % 64) / 2; }
__host__ __device__ __forceinline__ int perm32(int rho) { const int n = rho >> 4, i = rho & 15; return 8 * (i >> 2) + 4 * n + (i & 3); }

struct Unit { int pm, pn, sub; };

__device__ __forceinline__ void tile_of(int L, int nM, int nN, int nwg, Unit& u) {
    int wgid = L; { const int q = nwg / NXCD, r = nwg % NXCD, xcd = wgid % NXCD, off = wgid / NXCD; wgid = (xcd < r ? xcd * (q + 1) : r * (q + 1) + (xcd - r) * q) + off; }
    const int nig = WGM * nN, gid = wgid / nig, fm = gid * WGM, gsz = (nM - fm) < WGM ? (nM - fm) : WGM;
    u.pm = fm + ((wgid % nig) % gsz); u.pn = (wgid % nig) / gsz;
}
struct SchedG {
    int nM, nN, nwg, G, c; const char* A; const char* B;
    __device__ void init(int M_, int N_, int G_, int c_, const void* A_, const void* B_) { nM = M_ / BM; nN = N_ / BM; nwg = nM * nN; G = G_; c = c_; A = (const char*)A_; B = (const char*)B_; }
    __device__ __forceinline__ bool next(int i, Unit& u) const { const long L = (long)i * G + c; if (L >= nwg) return false; tile_of((int)L, nM, nN, nwg, u); u.sub = 0; return true; }
    __device__ __forceinline__ const char* abase(const Unit&) const { return A; }
    __device__ __forceinline__ const char* bbase(const Unit&) const { return B; }
};
struct SchedMerge {
    int nM, nN, nwg, G, c; const char* ws;
    __device__ __forceinline__ bool next(int i, Unit& u) const { const long L = (long)(i >> 2) * G + c; if (L >= nwg) return false; tile_of((int)L, nM, nN, nwg, u); u.sub = i & 3; return true; }
    __device__ __forceinline__ const char* abase(const Unit& u) const { const size_t off = u.sub < 2 ? WS_XB : (u.sub == 2 ? WS_QA : WS_QB); return ws + off; }
    __device__ __forceinline__ const char* bbase(const Unit& u) const {
        const size_t off = u.sub == 0 ? (WS_WIN + (size_t)4608 * 2048) : (u.sub == 1 ? (WS_WIN + (size_t)5632 * 2048) : (u.sub == 2 ? WS_WA : WS_WB)); return ws + off; }
};

struct EpiQKV {
    static constexpr bool PERM = true;
    bf16_t* q4; bf16_t* kb; bf16_t* vb;
    __device__ __forceinline__ void operator()(const f32x4 (&acc)[2][2][4][2], const Unit& u, int wr, int wc, int fr, int fq) const {
        bf16_t* base; int ldc, colt;
        if (u.pn < 16) { base = q4 + (size_t)(u.pn >> 2) * ((size_t)M * 1024); ldc = 1024; colt = (u.pn & 3) * 256; }
        else if (u.pn == 16) { base = kb; ldc = 256; colt = 0; } else { base = vb; ldc = 256; colt = 0; }
        const int row0 = u.pm * BM + wr * 64 + fr, col0 = colt + wc * 32 + 8 * fq;
#pragma unroll
        for (int ai = 0; ai < 2; ++ai)
#pragma unroll
            for (int m = 0; m < 4; ++m) { bf16_t* rowp = base + (size_t)(row0 + ai * HALF + m * 16) * ldc + col0;
#pragma unroll
                for (int bj = 0; bj < 2; ++bj) { const f32x4 v0 = acc[ai][bj][m][0], v1 = acc[ai][bj][m][1];
                    u32x4 w; w.x = cvt_pk_bf16(v0[0], v0[1]); w.y = cvt_pk_bf16(v0[2], v0[3]); w.z = cvt_pk_bf16(v1[0], v1[1]); w.w = cvt_pk_bf16(v1[2], v1[3]);
                    *(u32x4*)(rowp + bj * HALF) = w; } }
    }
};
__device__ __forceinline__ float sigmoidf_(float a) { return __builtin_amdgcn_rcpf(1.f + __builtin_amdgcn_exp2f(-1.4426950408889634f * a)); }
#define OPAQUE_V(x) asm volatile("" : "+v"(x))
struct EpiMerge {
    static constexpr bool PERM = true;
    unsigned char* s1; unsigned char* s3; bf16_t* mg;
    __device__ __forceinline__ void operator()(const f32x4 (&acc)[2][2][4][2], const Unit& u, int wr, int wc, int fr, int fq) const {
        const int sub = __builtin_amdgcn_readfirstlane(u.sub);
        unsigned tid = threadIdx.x; OPAQUE_V(tid);
        if (sub < 2) {
            unsigned char* sg = s1 + (sub ? 131072 : 0);
#pragma unroll
            for (int ai = 0; ai < 2; ++ai)
#pragma unroll
                for (int m = 0; m < 4; ++m) {
                    unsigned t2 = tid; OPAQUE_V(t2); unsigned char* p = sg + (ai * 8 + m * 2) * 8192 + t2 * 16u;
#pragma unroll
                    for (int bj = 0; bj < 2; ++bj) {
                        const f32x4 v0 = acc[ai][bj][m][0], v1 = acc[ai][bj][m][1];
                        u32x4 w; w.x = cvt_pk_bf16(sigmoidf_(v0[0]), sigmoidf_(v0[1])); w.y = cvt_pk_bf16(sigmoidf_(v0[2]), sigmoidf_(v0[3]));
                        w.z = cvt_pk_bf16(sigmoidf_(v1[0]), sigmoidf_(v1[1])); w.w = cvt_pk_bf16(sigmoidf_(v1[2]), sigmoidf_(v1[3]));
                        *(u32x4*)(p + bj * 8192) = w; } }
        } else if (sub == 2) {
#pragma unroll
            for (int ai = 0; ai < 2; ++ai)
#pragma unroll
                for (int m = 0; m < 4; ++m) {
                    unsigned t2 = tid; OPAQUE_V(t2); const unsigned char* p = s1 + (ai * 8 + m * 2) * 8192 + t2 * 16u; unsigned char* q = s3 + (ai * 8 + m * 2) * 16384 + t2 * 32u;
#pragma unroll
                    for (int bj = 0; bj < 2; ++bj) {
                        const f32x4 v0 = acc[ai][bj][m][0], v1 = acc[ai][bj][m][1];
                        const u32x4 g = *(const u32x4*)(p + bj * 8192);
                        const f32x4 g0 = {bf2f(g.x & 0xffffu), bf2f(g.x >> 16), bf2f(g.y & 0xffffu), bf2f(g.y >> 16)};
                        const f32x4 g1 = {bf2f(g.z & 0xffffu), bf2f(g.z >> 16), bf2f(g.w & 0xffffu), bf2f(g.w >> 16)};
                        *(f32x4*)(q + bj * 16384) = g0 * v0; *(f32x4*)(q + bj * 16384 + 16) = g1 * v1; }
                    asm volatile("" ::: "memory"); }
        } else {
            unsigned char* mgu = (unsigned char*)mg + (size_t)u.pm * (256 * 2048) + u.pn * 512;
#pragma unroll
            for (int ai = 0; ai < 2; ++ai)
#pragma unroll
                for (int m = 0; m < 4; ++m) {
                    unsigned t2 = tid; OPAQUE_V(t2); const unsigned char* p = s1 + 131072 + (ai * 8 + m * 2) * 8192 + t2 * 16u; const unsigned char* q = s3 + (ai * 8 + m * 2) * 16384 + t2 * 32u;
                    const unsigned lane_off = ((t2 >> 8) * 64 + (t2 & 15)) * 2048u + (((t2 >> 6) & 3) * 32 + 8 * ((t2 >> 4) & 3)) * 2u;
                    unsigned char* r = mgu + (ai * HALF + m * 16) * 2048 + lane_off;
#pragma unroll
                    for (int bj = 0; bj < 2; ++bj) {
                        const f32x4 v0 = acc[ai][bj][m][0], v1 = acc[ai][bj][m][1];
                        const u32x4 g = *(const u32x4*)(p + bj * 8192);
                        const f32x4 g0 = {bf2f(g.x & 0xffffu), bf2f(g.x >> 16), bf2f(g.y & 0xffffu), bf2f(g.y >> 16)};
                        const f32x4 g1 = {bf2f(g.z & 0xffffu), bf2f(g.z >> 16), bf2f(g.w & 0xffffu), bf2f(g.w >> 16)};
                        const f32x4 t0 = g0 * v0 + *(const f32x4*)(q + bj * 16384), t1 = g1 * v1 + *(const f32x4*)(q + bj * 16384 + 16);
                        u32x4 w; w.x = cvt_pk_bf16(t0[0], t0[1]); w.y = cvt_pk_bf16(t0[2], t0[3]); w.z = cvt_pk_bf16(t1[0], t1[1]); w.w = cvt_pk_bf16(t1[2], t1[3]);
                        *(u32x4*)(r + bj * 256) = w; }
                    asm volatile("" ::: "memory"); }
        }
    }
};
struct EpiWo {
    static constexpr bool PERM = false;
    const float* xp; const float* xs; float* out;
    __device__ __forceinline__ void operator()(const f32x4 (&acc)[2][2][4][2], const Unit& u, int wr, int wc, int fr, int fq) const {
        const int row0 = u.pm * BM + wr * 64 + fr, col0 = u.pn * BM + wc * 32 + 4 * fq;
        const float* xb = (row0 < M_P) ? xp : (xs - (size_t)M_P * 1024);
#pragma unroll
        for (int ai = 0; ai < 2; ++ai)
#pragma unroll
            for (int m = 0; m < 4; ++m) { const size_t off = (size_t)(row0 + ai * HALF + m * 16) * 1024 + col0;
#pragma unroll
                for (int bj = 0; bj < 2; ++bj)
#pragma unroll
                    for (int n = 0; n < 2; ++n) { const f32x4 xv = *(const f32x4*)(xb + off + bj * HALF + n * 16);
                        *(f32x4*)(out + off + bj * HALF + n * 16) = xv * ALPHA + acc[ai][bj][m][n]; } }
    }
};
struct EpiGU {
    static constexpr bool PERM = true;
    bf16_t* act;
    __device__ __forceinline__ void operator()(const f32x4 (&acc)[2][2][4][2], const Unit& u, int wr, int wc, int fr, int fq) const {
        const int row0 = u.pm * BM + wr * 64 + fr, col0 = u.pn * HALF + wc * 32 + 8 * fq;
#pragma unroll
        for (int ai = 0; ai < 2; ++ai)
#pragma unroll
            for (int m = 0; m < 4; ++m) {
                f32x4 r0, r1;
#pragma unroll
                for (int j = 0; j < 4; ++j) { const float g0 = acc[ai][0][m][0][j], g1 = acc[ai][0][m][1][j];
                    r0[j] = g0 * sigmoidf_(g0) * acc[ai][1][m][0][j]; r1[j] = g1 * sigmoidf_(g1) * acc[ai][1][m][1][j]; }
                u32x4 w; w.x = cvt_pk_bf16(r0[0], r0[1]); w.y = cvt_pk_bf16(r0[2], r0[3]); w.z = cvt_pk_bf16(r1[0], r1[1]); w.w = cvt_pk_bf16(r1[2], r1[3]);
                *(u32x4*)(act + (size_t)(row0 + ai * HALF + m * 16) * DFF + col0) = w; }
    }
};
struct EpiDown {
    static constexpr bool PERM = false;
    float* out;
    __device__ __forceinline__ void operator()(const f32x4 (&acc)[2][2][4][2], const Unit& u, int wr, int wc, int fr, int fq) const {
        const int row0 = u.pm * BM + wr * 64 + fr, col0 = u.pn * BM + wc * 32 + 4 * fq;
#pragma unroll
        for (int ai = 0; ai < 2; ++ai)
#pragma unroll
            for (int m = 0; m < 4; ++m) { const size_t off = (size_t)(row0 + ai * HALF + m * 16) * 1024 + col0;
#pragma unroll
                for (int bj = 0; bj < 2; ++bj)
#pragma unroll
                    for (int n = 0; n < 2; ++n) { float* p = out + off + bj * HALF + n * 16; const f32x4 hv = *(const f32x4*)p;
                        *(f32x4*)p = hv * ALPHA + acc[ai][bj][m][n]; } }
    }
};

template <class Epi, class Sched>
__device__ __forceinline__ void gemm_phase(LAS unsigned char* lds, const int K, const Sched& S, const Epi& E) {
    int tid_ = threadIdx.x; asm volatile("" : "+v"(tid_));
    const int tid = tid_, wid = __builtin_amdgcn_readfirstlane(tid >> 6), lane = tid & 63, wr = wid >> 2, wc = wid & 3, fr = lane & 15, fq = lane >> 4;
    const int nt = K / BK;
    unsigned voffA[2], voffB[2];
#pragma unroll
    for (int i = 0; i < 2; ++i) { int R, C; stage_rc(tid * 16 + i * 8192, R, C); const int Rb = Epi::PERM ? ((R & ~31) + perm32(R & 31)) : R;
        voffA[i] = (unsigned)(R * K + C) * 2u; voffB[i] = (unsigned)(Rb * K + C) * 2u; }
    const size_t kstep = (size_t)(BK * 2);
    const size_t hstep = (size_t)HALF * K * 2;
    const size_t tstep = 2 * hstep;
    const unsigned ldsw = (unsigned)wid * 1024u;
    const int aoff = lds_byte(wr * 64 + fr, fq * 8), boff = lds_byte(wc * 32 + fr, fq * 8);
#define PG8_SA(b, h) (((b) * 2 + (h)) * HTB)
#define PG8_SB(b, h) ((4 + (b) * 2 + (h)) * HTB)
#define PG8_STAGE(bufoff, gbase, voff) do { _Pragma("unroll") for (int _i = 0; _i < 2; ++_i) \
        __builtin_amdgcn_global_load_lds((const unsigned*)((const char*)(gbase) + (voff)[_i]), (LAS unsigned*)(lds + (bufoff) + ldsw + _i * 8192), 16, 0, 0); } while (0)
#define PG8_LDA(dst, b, h) do { _Pragma("unroll") for (int m = 0; m < 4; ++m) _Pragma("unroll") for (int k = 0; k < 2; ++k) dst[m][k] = *(const LAS bf16x8*)(lds + PG8_SA(b, h) + aoff + m * 2048 + k * 1024); } while (0)
#define PG8_LDB(dst, b, h) do { _Pragma("unroll") for (int n = 0; n < 2; ++n) _Pragma("unroll") for (int k = 0; k < 2; ++k) dst[n][k] = *(const LAS bf16x8*)(lds + PG8_SB(b, h) + boff + n * 2048 + k * 1024); } while (0)
#define PG8_MMA(ai, bj, At, Bt) do { __builtin_amdgcn_s_setprio(1); _Pragma("unroll") for (int m = 0; m < 4; ++m) _Pragma("unroll") for (int n = 0; n < 2; ++n) _Pragma("unroll") for (int k = 0; k < 2; ++k) \
        acc[ai][bj][m][n] = __builtin_amdgcn_mfma_f32_16x16x32_bf16(Bt[n][k], At[m][k], acc[ai][bj][m][n], 0, 0, 0); __builtin_amdgcn_s_setprio(0); } while (0)
#define PG8_WAIT_V(n) asm volatile("s_waitcnt vmcnt(" #n ")" ::: "memory")
#define PG8_WAIT_L(n) asm volatile("s_waitcnt lgkmcnt(" #n ")" ::: "memory")
#define PG8_BAR __builtin_amdgcn_s_barrier()
#define PG8_SCHED __builtin_amdgcn_sched_barrier(0)
    Unit cur, nxt; int ui = 0;
    if (!S.next(0, cur)) return;
    f32x4 acc[2][2][4][2];
#pragma unroll
    for (int a = 0; a < 2; ++a)
#pragma unroll
        for (int b = 0; b < 2; ++b)
#pragma unroll
            for (int m = 0; m < 4; ++m)
#pragma unroll
                for (int n = 0; n < 2; ++n) acc[a][b][m][n] = (f32x4){0.f, 0.f, 0.f, 0.f};
    bf16x8 At[4][2], B0[2][2], B1[2][2];
    const char* cA = S.abase(cur) + (size_t)cur.pm * tstep; const char* cB = S.bbase(cur) + (size_t)cur.pn * tstep;
    PG8_STAGE(PG8_SB(0, 0), cB, voffB); PG8_STAGE(PG8_SB(0, 1), cB + hstep, voffB); PG8_STAGE(PG8_SA(0, 0), cA, voffA); PG8_STAGE(PG8_SA(0, 1), cA + hstep, voffA);
    if (wr == 1) PG8_BAR;
    PG8_WAIT_V(2); PG8_BAR;
    PG8_STAGE(PG8_SB(1, 0), cB + kstep, voffB); PG8_STAGE(PG8_SA(1, 0), cA + kstep, voffA); PG8_STAGE(PG8_SB(1, 1), cB + hstep + kstep, voffB);
    PG8_WAIT_V(6); PG8_BAR;
    for (;;) {
        const bool has_next = S.next(ui + 1, nxt);
        const char* nA = has_next ? S.abase(nxt) + (size_t)nxt.pm * tstep : cA; const char* nB = has_next ? S.bbase(nxt) + (size_t)nxt.pn * tstep : cB;
        for (int t = 0; t < nt; t += 2) {
            const bool last = (t == nt - 2);
            const char* a1 = cA + (size_t)(t + 1) * kstep;
            const char* a2 = last ? nA : cA + (size_t)(t + 2) * kstep; const char* b2 = last ? nB : cB + (size_t)(t + 2) * kstep;
            const char* a3 = a2 + kstep; const char* b3 = b2 + kstep;
            PG8_LDB(B0, 0, 0); PG8_LDB(B1, 0, 1); PG8_SCHED; PG8_LDA(At, 0, 0); PG8_STAGE(PG8_SA(1, 1), a1 + hstep, voffA);
            PG8_WAIT_V(8); PG8_WAIT_L(0); PG8_BAR; PG8_MMA(0, 0, At, B0); PG8_MMA(0, 1, At, B1); PG8_BAR; PG8_SCHED;
            PG8_LDA(At, 0, 1); PG8_STAGE(PG8_SB(0, 0), b2, voffB); PG8_STAGE(PG8_SB(0, 1), b2 + hstep, voffB); PG8_STAGE(PG8_SA(0, 0), a2, voffA);
            PG8_WAIT_V(8); PG8_WAIT_L(0); PG8_BAR; PG8_MMA(1, 0, At, B0); PG8_MMA(1, 1, At, B1); PG8_BAR; PG8_SCHED;
            PG8_LDB(B0, 1, 0); PG8_LDB(B1, 1, 1); PG8_SCHED; PG8_LDA(At, 1, 0); PG8_STAGE(PG8_SA(0, 1), a2 + hstep, voffA);
            PG8_WAIT_V(8); PG8_WAIT_L(0); PG8_BAR; PG8_MMA(0, 0, At, B0); PG8_MMA(0, 1, At, B1); PG8_BAR; PG8_SCHED;
            PG8_LDA(At, 1, 1); PG8_STAGE(PG8_SB(1, 0), b3, voffB); PG8_STAGE(PG8_SB(1, 1), b3 + hstep, voffB); PG8_STAGE(PG8_SA(1, 0), a3, voffA);
            PG8_WAIT_V(8); PG8_WAIT_L(0); PG8_BAR; PG8_MMA(1, 0, At, B0); PG8_MMA(1, 1, At, B1); PG8_BAR; PG8_SCHED;
        }
        if (wr == 0) PG8_BAR;
        E(acc, cur, wr, wc, fr, fq);
        if (!has_next) break;
#pragma unroll
        for (int a = 0; a < 2; ++a)
#pragma unroll
            for (int b = 0; b < 2; ++b)
#pragma unroll
                for (int m = 0; m < 4; ++m)
#pragma unroll
                    for (int n = 0; n < 2; ++n) acc[a][b][m][n] = (f32x4){0.f, 0.f, 0.f, 0.f};
        cur = nxt; cA = nA; cB = nB; ++ui;
        if (wr == 1) PG8_BAR;
    }
    PG8_WAIT_V(0);
    PG8_BAR;
#undef PG8_SA
#undef PG8_SB
#undef PG8_STAGE
#undef PG8_LDA
#undef PG8_LDB
#undef PG8_MMA
#undef PG8_WAIT_V
#undef PG8_WAIT_L
#undef PG8_BAR
#undef PG8_SCHED
}
}

namespace att {
constexpr int NW = 8, KVBLK = 64;
constexpr int SHM_V = KVBLK * 128 * 2, SHM_K = KVBLK * 128 * 2;
constexpr int LDS_WS = 2 * SHM_V + 2 * SHM_K, LDS_BT = LDS_WS + NW * 64 * 4, LDS_ATT = LDS_BT + 448 * 4;
constexpr int BT_N = 448;
constexpr float THR = 8.f;
#define KSWZ(row, colB) ((row) * 256 + ((colB) ^ (((row) & 7) << 4)))
#define SBAR() __builtin_amdgcn_sched_barrier(0)
__device__ __forceinline__ int crow(int r, int hi) { return (r & 3) + 8 * (r >> 2) + 4 * hi; }
__device__ __forceinline__ unsigned cvtpk(float lo, float hi) { return cvt_pk_bf16(lo, hi); }

template <bool DIFF>
__device__ __forceinline__ void partialSM(f32x16& p0, f32x16& p1, float& m_reg, float& mn, float& alpha, const float cst) {
    constexpr float SCALE = DIFF ? 0.125f : 0.088388347648318440f;
    constexpr float C = SCALE * 1.4426950408889634f;
    float pmax = p0[0];
#pragma unroll
    for (int r = 1; r < 16; ++r) pmax = fmaxf(pmax, p0[r]);
#pragma unroll
    for (int r = 0; r < 16; ++r) pmax = fmaxf(pmax, p1[r]);
    { auto rr = __builtin_amdgcn_permlane32_swap(__float_as_uint(pmax), __float_as_uint(pmax), false, false);
      pmax = fmaxf(__uint_as_float(rr[0]), __uint_as_float(rr[1])); }
    pmax += cst;
    if (__builtin_expect(__all(pmax - m_reg <= THR / SCALE), 1)) { mn = m_reg; alpha = 1.f; }
    else { mn = fmaxf(m_reg, pmax); alpha = __builtin_amdgcn_exp2f((m_reg - mn) * C); m_reg = mn; }
    const float mnC = (cst - mn) * C;
#pragma unroll
    for (int r = 0; r < 16; ++r) p0[r] = fmaf(p0[r], C, mnC);
#pragma unroll
    for (int r = 0; r < 16; ++r) p1[r] = fmaf(p1[r], C, mnC);
#pragma unroll
    for (int r = 0; r < 16; ++r) p0[r] = __builtin_amdgcn_exp2f(p0[r]);
}
__device__ __forceinline__ void finishSM(f32x16& p0, f32x16& p1, float alpha, float& l_reg, bf16x8& pa0, bf16x8& pa1, bf16x8& pa2, bf16x8& pa3) {
#pragma unroll
    for (int r = 0; r < 16; ++r) p1[r] = __builtin_amdgcn_exp2f(p1[r]);
    float ps = 0;
#pragma unroll
    for (int r = 0; r < 16; ++r) ps += p0[r];
#pragma unroll
    for (int r = 0; r < 16; ++r) ps += p1[r];
    { auto rr = __builtin_amdgcn_permlane32_swap(__float_as_uint(ps), __float_as_uint(ps), false, false);
      ps = __uint_as_float(rr[0]) + __uint_as_float(rr[1]); }
    l_reg = l_reg * alpha + ps;
#define PK4(P, BASE, OUT) do { unsigned a0 = cvtpk(P[BASE + 0], P[BASE + 1]), a1 = cvtpk(P[BASE + 2], P[BASE + 3]);   \
    unsigned b0 = cvtpk(P[BASE + 4], P[BASE + 5]), b1 = cvtpk(P[BASE + 6], P[BASE + 7]);                              \
    auto r0 = __builtin_amdgcn_permlane32_swap(a0, b0, false, false); auto r1 = __builtin_amdgcn_permlane32_swap(a1, b1, false, false); \
    u32x4 w = {r0[0], r1[0], r0[1], r1[1]}; OUT = *reinterpret_cast<bf16x8*>(&w); } while (0)
    PK4(p0, 0, pa0); PK4(p0, 8, pa1); PK4(p1, 0, pa2); PK4(p1, 8, pa3);
#undef PK4
}
template <bool DIFF>
__device__ __forceinline__ void qkt(f32x16& p0, f32x16& p1, const bf16_t* Ks, const bf16x8* qr, int r32, int hi, int cofs) {
    p0 = f32x16{}; p1 = f32x16{};
#pragma unroll
    for (int d0 = 0; d0 < (DIFF ? 4 : 8); ++d0) { const int cb = (cofs + d0 * 16 + hi * 8) * 2;
        bf16x8 b0 = *reinterpret_cast<const bf16x8*>((const char*)Ks + KSWZ(r32, cb));
        bf16x8 b1 = *reinterpret_cast<const bf16x8*>((const char*)Ks + KSWZ(32 + r32, cb));
        p0 = __builtin_amdgcn_mfma_f32_32x32x16_bf16(b0, qr[d0], p0, 0, 0, 0);
        p1 = __builtin_amdgcn_mfma_f32_32x32x16_bf16(b1, qr[d0], p1, 0, 0, 0); }
}
__device__ __forceinline__ int v_st(int k, int c) { const int kk = (k & ~0xC) | ((k & 4) << 1) | ((k & 8) >> 1); return ((kk >> 3) * 4 + (c >> 5)) * 512 + ((kk & 7) * 32 + (c & 31)) * 2; }
__device__ __forceinline__ int v_rd_base(int lane) { return ((lane & 3) << 3) | (((lane >> 2) & 3) << 6) | (((lane >> 4) & 1) << 5) | (((lane >> 5) & 1) << 8); }
constexpr int v_rd_off(int d0, int ks, int half) { return d0 * 512 + ks * 4096 + half * 2048; }
template <int OFF> __device__ __forceinline__ s16x4 tr_read(int vb) {
    s16x4 r; asm volatile("ds_read_b64_tr_b16 %0, %1 offset:%2" : "=&v"(r) : "v"(vb), "i"(OFF) : "memory"); return r;
}
template <int D0> __device__ __forceinline__ void pv_one(f32x16& od, int vb, bf16x8 pa0, bf16x8 pa1, bf16x8 pa2, bf16x8 pa3) {
    const s16x4 l0 = tr_read<v_rd_off(D0, 0, 0)>(vb), h0 = tr_read<v_rd_off(D0, 0, 1)>(vb), l1 = tr_read<v_rd_off(D0, 1, 0)>(vb), h1 = tr_read<v_rd_off(D0, 1, 1)>(vb);
    const s16x4 l2 = tr_read<v_rd_off(D0, 2, 0)>(vb), h2 = tr_read<v_rd_off(D0, 2, 1)>(vb), l3 = tr_read<v_rd_off(D0, 3, 0)>(vb), h3 = tr_read<v_rd_off(D0, 3, 1)>(vb);
    asm volatile("s_waitcnt lgkmcnt(0)" ::: "memory"); SBAR();
#define PK(L, H) (bf16x8){L[0], L[1], L[2], L[3], H[0], H[1], H[2], H[3]}
    od = __builtin_amdgcn_mfma_f32_32x32x16_bf16(pa0, PK(l0, h0), od, 0, 0, 0);
    od = __builtin_amdgcn_mfma_f32_32x32x16_bf16(pa1, PK(l1, h1), od, 0, 0, 0);
    od = __builtin_amdgcn_mfma_f32_32x32x16_bf16(pa2, PK(l2, h2), od, 0, 0, 0);
    od = __builtin_amdgcn_mfma_f32_32x32x16_bf16(pa3, PK(l3, h3), od, 0, 0, 0);
#undef PK
}
__device__ __forceinline__ void pv_d0(f32x16* o, int vb, bf16x8 pa0, bf16x8 pa1, bf16x8 pa2, bf16x8 pa3) {
    pv_one<0>(o[0], vb, pa0, pa1, pa2, pa3); pv_one<1>(o[1], vb, pa0, pa1, pa2, pa3); pv_one<2>(o[2], vb, pa0, pa1, pa2, pa3); pv_one<3>(o[3], vb, pa0, pa1, pa2, pa3);
}

template <bool DIFF>
__device__ __forceinline__ void attn_unit(const bf16_t* __restrict__ Qb, const bf16_t* __restrict__ Kh, const bf16_t* __restrict__ Vh, bf16_t* __restrict__ Ob,
                                          const int seq, const int qpos0, char* lds,
                                          const float* __restrict__ btab_g, const float* __restrict__ lamp, const float* __restrict__ subg,
                                          const float* __restrict__ qg, const f32x2* __restrict__ tabR, const f32x2* __restrict__ tabC) {
    int tid_ = threadIdx.x; asm volatile("" : "+v"(tid_));
    const int tid = tid_, wid = __builtin_amdgcn_readfirstlane(tid >> 6), lane = tid & 63, r32 = lane & 31, hi = lane >> 5;
    constexpr int ldq = 1024, ldk = DIFF ? 1024 : 256;
    bf16_t* V_lds = (bf16_t*)lds; bf16_t* K_lds = (bf16_t*)(lds + 2 * SHM_V);
    float* wsp = (float*)(lds + LDS_WS) + wid * 64; float* li_l = wsp; float* al_l = wsp + 32;
    float* btab = (float*)(lds + LDS_BT);
    const int cmap = DIFF ? (wid >> 2) : 0;
    const int wrow = DIFF ? ((wid & 3) * 32) : (wid * 32);
    const int qw = qpos0 + wrow;
    float cL = 0.f, cR = 0.f;
    if constexpr (DIFF) { cL = __uint_as_float(__builtin_amdgcn_readfirstlane(__float_as_uint(btab_g[0]))); cR = __uint_as_float(__builtin_amdgcn_readfirstlane(__float_as_uint(btab_g[BT_N - 1]))); }
    __syncthreads();
    if (DIFF) { if (tid < BT_N) btab[tid] = btab_g[tid]; }
    float m_reg = -1e30f, l_reg = 0; f32x16 o[4] = {}; bf16x8 qr[DIFF ? 4 : 8];
    const bf16_t* Qw = Qb + (long)(wrow + r32) * ldq + cmap * 64 + hi * 8;
#pragma unroll
    for (int d0 = 0; d0 < (DIFF ? 4 : 8); ++d0) qr[d0] = *reinterpret_cast<const bf16x8*>(Qw + d0 * 16);
    if constexpr (!DIFF) {
        float ss = 0.f;
#pragma unroll
        for (int d0 = 0; d0 < 8; ++d0)
#pragma unroll
            for (int j = 0; j < 8; ++j) { const float v = bf2f((unsigned short)qr[d0][j]); ss += v * v; }
        { auto rr = __builtin_amdgcn_permlane32_swap(__float_as_uint(ss), __float_as_uint(ss), false, false); ss = __uint_as_float(rr[0]) + __uint_as_float(rr[1]); }
        const float rs = __builtin_amdgcn_rsqf(ss * (1.f / 128.f) + RMS_EPS);
        const int t = qpos0 + wrow + r32;
        const f32x2* tr = tabR + (t >> 6) * 32 + hi * 8; const f32x2* tc = tabC + (t & 63) * 32 + hi * 8;
#pragma unroll
        for (int dd = 0; dd < 4; ++dd) {
            const int d0 = (dd & 1) + (dd >> 1) * 4; const f32x2* tb = ((dd >> 1) ? tc : tr) + (dd & 1) * 16;
            const float* ga = qg + d0 * 16 + hi * 8; const float* gb = ga + 32;
            bf16x8 oa, ob;
#pragma unroll
            for (int j = 0; j < 8; ++j) { const f32x2 cs = tb[j];
                const float a = bf2f((unsigned short)qr[d0][j]) * rs * ga[j], b = bf2f((unsigned short)qr[d0 + 2][j]) * rs * gb[j];
                oa[j] = (short)f2bf(a * cs.x - b * cs.y); ob[j] = (short)f2bf(b * cs.x + a * cs.y); }
            qr[d0] = oa; qr[d0 + 2] = ob; }
    }
    const int sr = tid >> 4, sc = (tid & 15) * 8, vst0 = v_st(sr, sc), vst1 = v_st(32 + sr, sc);
    const int vb0 = (int)(uintptr_t)V_lds + v_rd_base(lane);
    struct { bf16x8 vs0, vs1, ks0, ks1; } sr_[2];
#define SLOAD(i, k0) do { sr_[i].vs0 = *(const bf16x8*)(&Vh[(long)((k0) + sr) * ldk + sc]); sr_[i].vs1 = *(const bf16x8*)(&Vh[(long)((k0) + 32 + sr) * ldk + sc]); \
    sr_[i].ks0 = *(const bf16x8*)(&Kh[(long)((k0) + sr) * ldk + sc]); sr_[i].ks1 = *(const bf16x8*)(&Kh[(long)((k0) + 32 + sr) * ldk + sc]); } while (0)
#define SWRITE(b, i) do { *(bf16x8*)((char*)V_lds + (b) * SHM_V + vst0) = sr_[i].vs0;          \
    *(bf16x8*)((char*)V_lds + (b) * SHM_V + vst1) = sr_[i].vs1; const int kc = sc * 2;               \
    *(bf16x8*)((char*)K_lds + (b) * SHM_K + KSWZ(sr, kc)) = sr_[i].ks0;                       \
    *(bf16x8*)((char*)K_lds + (b) * SHM_K + KSWZ(32 + sr, kc)) = sr_[i].ks1; } while (0)
#define SWAIT() asm volatile("s_waitcnt vmcnt(4)" ::: "memory")
#define RESC(a) do { if (__any((a) < 1.f)) { if (hi == 0) al_l[r32] = (a); asm volatile("s_waitcnt lgkmcnt(0)" ::: "memory"); \
    _Pragma("unroll") for (int d = 0; d < 4; ++d) _Pragma("unroll") for (int r = 0; r < 16; ++r) o[d][r] *= al_l[crow(r, hi)]; } } while (0)
#define BIAS(P0, P1, K0, CST) do { if constexpr (DIFF) { const int kq = (K0) - qw; if (kq > -191 && kq < 159) { CST = 0.f; const float* bp_ = btab + (kq - r32 + 4 * hi + 224); \
    _Pragma("unroll") for (int r = 0; r < 16; ++r) { const int off = (r & 3) + 8 * (r >> 2); P0[r] += bp_[off]; P1[r] += bp_[off + 32]; } } else CST = kq < 0 ? cL : cR; } else CST = 0.f; } while (0)
    f32x16 pA0, pA1, pB0, pB1; float mnA, mnB, alA, alB, cstA, cstB; bf16x8 pa0, pa1, pa2, pa3; const int NT = seq / KVBLK;
    constexpr int SE = 0, SO = 1;
    const int cofs = cmap * 64;
    SLOAD(SE, 0); asm volatile("s_waitcnt vmcnt(0)" ::: "memory"); SWRITE(0, SE); __syncthreads();
    qkt<DIFF>(pA0, pA1, K_lds, qr, r32, hi, cofs); BIAS(pA0, pA1, 0, cstA); partialSM<DIFF>(pA0, pA1, m_reg, mnA, alA, cstA);
    SLOAD(SO, KVBLK); if (2 < NT) SLOAD(SE, 2 * KVBLK);
    SWAIT(); SWRITE(1, SO); __syncthreads();
    for (int j = 1; j + 1 < NT; j += 2) {
        SBAR(); qkt<DIFF>(pB0, pB1, (bf16_t*)((char*)K_lds + SHM_K), qr, r32, hi, cofs);
        finishSM(pA0, pA1, alA, l_reg, pa0, pa1, pa2, pa3); SBAR();
        SLOAD(SO, (j + 2) * KVBLK); SBAR();
        pv_d0(o, vb0, pa0, pa1, pa2, pa3); BIAS(pB0, pB1, j * KVBLK, cstB); partialSM<DIFF>(pB0, pB1, m_reg, mnB, alB, cstB);
        __syncthreads(); SWAIT(); SWRITE(0, SE);
        RESC(alB); __syncthreads();
        SBAR(); qkt<DIFF>(pA0, pA1, K_lds, qr, r32, hi, cofs);
        finishSM(pB0, pB1, alB, l_reg, pa0, pa1, pa2, pa3); SBAR();
        if (j + 3 < NT) SLOAD(SE, (j + 3) * KVBLK); SBAR();
        pv_d0(o, vb0 + SHM_V, pa0, pa1, pa2, pa3); BIAS(pA0, pA1, (j + 1) * KVBLK, cstA); partialSM<DIFF>(pA0, pA1, m_reg, mnA, alA, cstA);
        __syncthreads(); SWAIT(); SWRITE(1, SO);
        RESC(alA); __syncthreads();
    }
    SBAR(); qkt<DIFF>(pB0, pB1, (bf16_t*)((char*)K_lds + SHM_K), qr, r32, hi, cofs);
    finishSM(pA0, pA1, alA, l_reg, pa0, pa1, pa2, pa3); SBAR();
    pv_d0(o, vb0, pa0, pa1, pa2, pa3); BIAS(pB0, pB1, (NT - 1) * KVBLK, cstB); partialSM<DIFF>(pB0, pB1, m_reg, mnB, alB, cstB);
    __syncthreads(); RESC(alB);
    finishSM(pB0, pB1, alB, l_reg, pa0, pa1, pa2, pa3); SBAR();
    pv_d0(o, vb0 + SHM_V, pa0, pa1, pa2, pa3);
    if (hi == 0) li_l[r32] = l_reg; asm volatile("s_waitcnt lgkmcnt(0)" ::: "memory");
    float rli[16];
#pragma unroll
    for (int r = 0; r < 16; ++r) rli[r] = __builtin_amdgcn_rcpf(li_l[crow(r, hi)]);
    if constexpr (!DIFF) {
        bf16_t* Ow = Ob + (long)wrow * ldq;
#pragma unroll
        for (int r = 0; r < 16; ++r) { const int orow = crow(r, hi);
#pragma unroll
            for (int d0 = 0; d0 < 4; ++d0) Ow[(long)orow * ldq + d0 * 32 + r32] = (bf16_t)f2bf(o[d0][r] * rli[r]); }
    } else {
        __syncthreads();
        float* xch = (float*)lds;
        const float lam = __uint_as_float(__builtin_amdgcn_readfirstlane(__float_as_uint(lamp[0])));
        if (cmap == 1) {
#pragma unroll
            for (int r = 0; r < 16; ++r) { const int row = wrow + crow(r, hi);
#pragma unroll
                for (int d0 = 0; d0 < 4; ++d0) xch[row * 128 + d0 * 32 + r32] = o[d0][r] * rli[r] * lam; }
        }
        __syncthreads();
        if (cmap == 0) {
            float g[4];
#pragma unroll
            for (int d0 = 0; d0 < 4; ++d0) g[d0] = subg[d0 * 32 + r32] * (1.f - LAM_INIT);
#pragma unroll
            for (int r = 0; r < 16; ++r) { const int row = wrow + crow(r, hi); float v[4]; float ss = 0.f;
#pragma unroll
                for (int d0 = 0; d0 < 4; ++d0) { v[d0] = o[d0][r] * rli[r] - xch[row * 128 + d0 * 32 + r32]; ss += v[d0] * v[d0]; }
                ss += __shfl_xor(ss, 1); ss += __shfl_xor(ss, 2); ss += __shfl_xor(ss, 4); ss += __shfl_xor(ss, 8); ss += __shfl_xor(ss, 16);
                const float rs = __builtin_amdgcn_rsqf(ss * (1.f / 128.f) + RMS_EPS);
#pragma unroll
                for (int d0 = 0; d0 < 4; ++d0) Ob[(long)row * ldq + d0 * 32 + r32] = (bf16_t)f2bf(v[d0] * rs * g[d0]); }
        }
    }
#undef SLOAD
#undef SWRITE
#undef SWAIT
#undef RESC
#undef BIAS
}
}

__device__ __forceinline__ void p0_transpose_item(const float* W, int K, int N, bf16_t* WT, int dst_row0, LAS float* scr, int k0, int n0, int lane) {
#pragma unroll
    for (int i = 0; i < 32; ++i) { const int kk = 2 * i + (lane >> 5); scr[kk * 33 + (lane & 31)] = W[(size_t)(k0 + kk) * N + n0 + (lane & 31)]; }
    asm volatile("s_waitcnt lgkmcnt(0)" ::: "memory");
    const int c = lane & 7;
#pragma unroll
    for (int j = 0; j < 4; ++j) { const int n = (lane >> 3) + 8 * j; const LAS float* s = scr + (8 * c) * 33 + n;
        u32x4 o; o.x = cvt_pk_bf16(s[0 * 33], s[1 * 33]); o.y = cvt_pk_bf16(s[2 * 33], s[3 * 33]); o.z = cvt_pk_bf16(s[4 * 33], s[5 * 33]); o.w = cvt_pk_bf16(s[6 * 33], s[7 * 33]);
        *(u32x4*)(WT + (size_t)(dst_row0 + n) * K + k0 + 8 * c) = o; }
    asm volatile("s_waitcnt lgkmcnt(0)" ::: "memory");
}
__device__ __forceinline__ int t5_bucket_dev(int rel) {
    const int n = rel < 0 ? -rel : rel; int b;
    if (n < 8) b = n; else if (n < 12) b = 8; else if (n < 16) b = 9; else if (n < 23) b = 10; else if (n < 32) b = 11; else if (n < 46) b = 12; else if (n < 64) b = 13; else if (n < 91) b = 14; else b = 15;
    return b + (rel > 0 ? 16 : 0);
}

struct Args { const float* in[21]; float* out; unsigned char* ws; int ph_lo, ph_hi; };

__global__ void __launch_bounds__(512, 2) enc_fwd(Args args) {
    extern __shared__ __attribute__((aligned(16))) unsigned char lds[];
    const int tid = threadIdx.x, lane = tid & 63, wave = __builtin_amdgcn_readfirstlane(tid >> 6);
    const int G = gridDim.x, bx = blockIdx.x;
    unsigned char* ws = args.ws;
    const int lo = args.ph_lo, hi_ = args.ph_hi;
#ifndef PH_MASK
#define PH_MASK 0x3ff
#endif
#ifndef REP_MASK
#define REP_MASK 0
#endif
#ifndef ATT_REP
#define ATT_REP 1
#endif
#ifndef ATT_SEL
#define ATT_SEL 0
#endif
#define NREP(k) (((REP_MASK >> (k)) & 1) ? 2 : 1)
#define IN(k) (((PH_MASK >> (k)) & 1) && lo <= (k) && (k) < hi_)
#define SEAM(k) do { if (lo <= (k) && (k) + 1 < hi_) { __threadfence(); cg::this_grid().sync(); } } while (0)
    const float* x_p = args.in[0]; const float* x_s = args.in[1];
    bf16_t* XB = (bf16_t*)(ws + WS_XB); bf16_t* QA = (bf16_t*)(ws + WS_QA); bf16_t* KA = (bf16_t*)(ws + WS_KA); bf16_t* VA = (bf16_t*)(ws + WS_VA);
    bf16_t* QB = (bf16_t*)(ws + WS_QB); bf16_t* KB = (bf16_t*)(ws + WS_KB); bf16_t* VB = (bf16_t*)(ws + WS_VB);
    bf16_t* WinT = (bf16_t*)(ws + WS_WIN); bf16_t* WaT = (bf16_t*)(ws + WS_WA); bf16_t* WbT = (bf16_t*)(ws + WS_WB); bf16_t* WoT = (bf16_t*)(ws + WS_WO);
    bf16_t* WguT = (bf16_t*)(ws + WS_WGU); bf16_t* WdT = (bf16_t*)(ws + WS_WD);
    f32x2* tabR = (f32x2*)(ws + WS_TBL_R); f32x2* tabC = (f32x2*)(ws + WS_TBL_C); float* tabB = (float*)(ws + WS_TBL_BIAS); float* tabL = (float*)(ws + WS_TBL_LAM);
    const int gw = bx * 8 + wave, NGW = G * 8;

    for (int rep = 0; rep < NREP(0); ++rep) if (IN(0)) {
        if (rep) { __threadfence(); cg::this_grid().sync(); }
        LAS float* scr = (LAS float*)((LAS unsigned char*)lds + wave * 16384);
        constexpr int I0 = 16 * 208, I1 = 16 * 32, I4 = 16 * 88, I6 = 44 * 32;
        constexpr int NITEMS = I0 + 3 * I1 + 2 * I4 + I6;
        for (int it = gw; it < NITEMS; it += NGW) {
            int r = it;
            if (r < I0) { const int kb = r / 208, nb = r % 208; p0_transpose_item(args.in[2], 1024, NIN, WinT, nb * 32, scr, kb * 64, nb * 32, lane); continue; } r -= I0;
            if (r < I1) { const int kb = r / 32, nb = r % 32; p0_transpose_item(args.in[11], 1024, 1024, WaT, nb * 32, scr, kb * 64, nb * 32, lane); continue; } r -= I1;
            if (r < I1) { const int kb = r / 32, nb = r % 32; p0_transpose_item(args.in[12], 1024, 1024, WbT, nb * 32, scr, kb * 64, nb * 32, lane); continue; } r -= I1;
            if (r < I1) { const int kb = r / 32, nb = r % 32; p0_transpose_item(args.in[13], 1024, 1024, WoT, nb * 32, scr, kb * 64, nb * 32, lane); continue; } r -= I1;
            if (r < I4) { const int kb = r / 88, nb = r % 88, n0 = nb * 32; p0_transpose_item(args.in[16], 1024, DFF, WguT, (n0 >> 7) * 256 + (n0 & 127), scr, kb * 64, n0, lane); continue; } r -= I4;
            if (r < I4) { const int kb = r / 88, nb = r % 88, n0 = nb * 32; p0_transpose_item(args.in[17], 1024, DFF, WguT, (n0 >> 7) * 256 + 128 + (n0 & 127), scr, kb * 64, n0, lane); continue; } r -= I4;
            { const int kb = r / 32, nb = r % 32; p0_transpose_item(args.in[18], DFF, 1024, WdT, nb * 32, scr, kb * 64, nb * 32, lane); }
        }
        { constexpr size_t n8 = (size_t)M * 1024 / 8, np8 = (size_t)M_P * 1024 / 8; const size_t stride = (size_t)G * 512;
          for (size_t i0 = (size_t)bx * 512 + tid; i0 < n8; i0 += 4 * stride) {
              f32x4 a[4], b[4];
#pragma unroll
              for (int u = 0; u < 4; ++u) { const size_t i = i0 + u * stride; if (i < n8) { const float* src = i < np8 ? x_p + i * 8 : x_s + (i - np8) * 8; a[u] = *(const f32x4*)src; b[u] = *(const f32x4*)(src + 4); } }
#pragma unroll
              for (int u = 0; u < 4; ++u) { const size_t i = i0 + u * stride; if (i < n8) {
                  u32x4 w; w.x = cvt_pk_bf16(a[u][0], a[u][1]); w.y = cvt_pk_bf16(a[u][2], a[u][3]); w.z = cvt_pk_bf16(b[u][0], b[u][1]); w.w = cvt_pk_bf16(b[u][2], b[u][3]);
                  *(u32x4*)(XB + i * 8) = w; } } } }
        for (int i = bx * 512 + tid; i < 192 * 32; i += G * 512) {
            const int p = i >> 5, f = i & 31; const int pos = p < 128 ? p : p - 128;
            const float freq = __builtin_amdgcn_exp2f(-(float)(2 * f) * (13.287712379549449f / 64.f));
            double rev = (double)((float)pos * freq) * 0.15915494309189535; rev -= __builtin_rint(rev);
            const float cs = __builtin_amdgcn_cosf((float)rev), sn = __builtin_amdgcn_sinf((float)rev);
            if (p < 128) tabR[p * 32 + f] = (f32x2){cs, sn}; else tabC[(p - 128) * 32 + f] = (f32x2){cs, sn};
        }
        for (int i = bx * 512 + tid; i < 8 * 448; i += G * 512) { const int h = i / 448, e = i % 448; int rel = e - 224; rel = rel < -128 ? -128 : (rel > 128 ? 128 : rel);
            tabB[i] = args.in[10][t5_bucket_dev(rel) * 8 + h] * 8.f; }
        if (bx == 0 && wave == 0) {
            const float a = wave_sum(args.in[3][lane] * args.in[4][lane]), b = wave_sum(args.in[5][lane] * args.in[6][lane]);
            if (lane == 0) tabL[0] = expf(a) - expf(b) + LAM_INIT;
        }
    }
    SEAM(0);

    for (int rep = 0; rep < NREP(1); ++rep) if (IN(1)) {
        if (rep) { __threadfence(); cg::this_grid().sync(); }
        pg8::SchedG S; S.init(M, NQKV, G, bx, XB, WinT);
        pg8::EpiQKV E{QA, KB, VB};
        pg8::gemm_phase<pg8::EpiQKV, pg8::SchedG>((LAS unsigned char*)lds, 1024, S, E);
    }
    SEAM(1);

    if (IN(2)) {
        const int rr = lane >> 3, c = lane & 7;
        constexpr int NIT = M * 2 / 16;
        const float* g = args.in[9];
        f32x4 gv[4];
#pragma unroll
        for (int q = 0; q < 4; ++q) gv[q] = *(const f32x4*)(g + q * 32 + c * 4);
        for (int it = gw; it < NIT; it += NGW) {
            u32x2 w[2][4]; bf16_t* pp[2]; int tt[2];
#pragma unroll
            for (int u = 0; u < 2; ++u) { const int r2 = it * 16 + u * 8 + rr, m = r2 >> 1; pp[u] = KB + (size_t)m * 256 + (r2 & 1) * 128;
                tt[u] = m < M_P ? (m & (S_P - 1)) : ((m - M_P) & (S_S - 1));
#pragma unroll
                for (int q = 0; q < 4; ++q) w[u][q] = *(const u32x2*)(pp[u] + q * 32 + c * 4); }
#pragma unroll
            for (int u = 0; u < 2; ++u) {
                float v[4][4];
#pragma unroll
                for (int q = 0; q < 4; ++q) { v[q][0] = bf2f(w[u][q].x & 0xffffu); v[q][1] = bf2f(w[u][q].x >> 16); v[q][2] = bf2f(w[u][q].y & 0xffffu); v[q][3] = bf2f(w[u][q].y >> 16); }
                float ss = 0.f;
#pragma unroll
                for (int q = 0; q < 4; ++q)
#pragma unroll
                    for (int j = 0; j < 4; ++j) ss += v[q][j] * v[q][j];
                ss += __shfl_xor(ss, 1); ss += __shfl_xor(ss, 2); ss += __shfl_xor(ss, 4);
                const float rs = __builtin_amdgcn_rsqf(ss * (1.f / 128.f) + RMS_EPS);
#pragma unroll
                for (int q = 0; q < 4; ++q)
#pragma unroll
                    for (int j = 0; j < 4; ++j) v[q][j] *= rs * gv[q][j];
                const f32x2* tr = tabR + (tt[u] >> 6) * 32 + c * 4; const f32x2* tc = tabC + (tt[u] & 63) * 32 + c * 4;
                float oa[4], ob[4], oc[4], od[4];
#pragma unroll
                for (int j = 0; j < 4; ++j) { const f32x2 a = tr[j], b = tc[j];
                    oa[j] = v[0][j] * a.x - v[1][j] * a.y; ob[j] = v[1][j] * a.x + v[0][j] * a.y;
                    oc[j] = v[2][j] * b.x - v[3][j] * b.y; od[j] = v[3][j] * b.x + v[2][j] * b.y; }
                u32x2 o[4];
                o[0].x = cvt_pk_bf16(oa[0], oa[1]); o[0].y = cvt_pk_bf16(oa[2], oa[3]); o[1].x = cvt_pk_bf16(ob[0], ob[1]); o[1].y = cvt_pk_bf16(ob[2], ob[3]);
                o[2].x = cvt_pk_bf16(oc[0], oc[1]); o[2].y = cvt_pk_bf16(oc[2], oc[3]); o[3].x = cvt_pk_bf16(od[0], od[1]); o[3].y = cvt_pk_bf16(od[2], od[3]);
#pragma unroll
                for (int q = 0; q < 4; ++q) *(u32x2*)(pp[u] + q * 32 + c * 4) = o[q];
            }
        }
    }
    SEAM(2);

    if (IN(3)) {
        const int xcd = bx & 7, l = bx >> 3;
        for (int arep = 0; arep < ATT_REP; ++arep)
        for (int rnd = 0; rnd < (G == 256 ? 30 : (7680 + G - 1) / G); ++rnd) {
            int b, h, qb, seq; size_t m0; bool diff;
            if (G == 256) {
                if (rnd < 2) { const int combo = xcd >> 1, u = (xcd & 1) * 64 + rnd * 32 + l; b = combo >> 1; h = (combo & 1) * 4 + (u >> 5); qb = u & 31; m0 = (size_t)b * S_P; seq = S_P; diff = false; }
                else if (rnd < 6) { const int r = rnd - 2, combo = 2 * xcd + (r >> 1); b = combo >> 3; h = combo & 7; qb = (r & 1) * 32 + l; m0 = (size_t)b * S_P; seq = S_P; diff = true; }
                else if (rnd < 14) { const int r = rnd - 6, combo = r * 8 + xcd; b = combo >> 1; h = (combo & 1) * 4 + (l >> 3); qb = l & 7; m0 = (size_t)M_P + (size_t)b * S_S; seq = S_S; diff = false; }
                else { const int r = rnd - 14, combo = (r * 8 + xcd) * 2 + (l >> 4); b = combo >> 3; h = combo & 7; qb = l & 15; m0 = (size_t)M_P + (size_t)b * S_S; seq = S_S; diff = true; }
            } else {
                const int idx = bx + rnd * G; if (idx >= 7680) break;
                if (idx < 512) { b = idx >> 8; h = (idx >> 5) & 7; qb = idx & 31; m0 = (size_t)b * S_P; seq = S_P; diff = false; }
                else if (idx < 1536) { const int i = idx - 512; b = i >> 9; h = (i >> 6) & 7; qb = i & 63; m0 = (size_t)b * S_P; seq = S_P; diff = true; }
                else if (idx < 3584) { const int i = idx - 1536; b = i >> 6; h = (i >> 3) & 7; qb = i & 7; m0 = (size_t)M_P + (size_t)b * S_S; seq = S_S; diff = false; }
                else { const int i = idx - 3584; b = i >> 7; h = (i >> 4) & 7; qb = i & 15; m0 = (size_t)M_P + (size_t)b * S_S; seq = S_S; diff = true; }
            }
            if (ATT_REP > 1 && (ATT_SEL == 1) && !diff && arep + 1 < ATT_REP) continue;
            if (ATT_REP > 1 && (ATT_SEL == 2) && diff && arep + 1 < ATT_REP) continue;
#ifndef NO_GQA
            if (!diff) { bf16_t* qp = QB + (m0 + (size_t)qb * 256) * 1024 + h * 128;
                att::attn_unit<false>(qp, KB + m0 * 256 + (h >> 2) * 128, VB + m0 * 256 + (h >> 2) * 128, (arep + 1 < ATT_REP) ? (bf16_t*)(ws + WS_END + (size_t)bx * 262144) : qp, seq, qb * 256, (char*)lds, nullptr, nullptr, nullptr, args.in[8], tabR, tabC); }
#endif
#ifndef NO_DIFF
            if (diff) { bf16_t* qp = QA + (m0 + (size_t)qb * 128) * 1024 + h * 128;
                att::attn_unit<true>(qp, KA + m0 * 1024 + h * 128, VA + m0 * 1024 + h * 128, (arep + 1 < ATT_REP) ? (bf16_t*)(ws + WS_END + (size_t)bx * 262144) : qp, seq, qb * 128, (char*)lds, tabB + h * 448, tabL, args.in[7], nullptr, nullptr, nullptr); }
#endif
        }
        __syncthreads();
    }
    SEAM(3);

    for (int rep = 0; rep < NREP(4); ++rep) if (IN(4)) {
        if (rep) { __threadfence(); cg::this_grid().sync(); }
        pg8::SchedMerge S{M / 256, 4, (M / 256) * 4, G, bx, (const char*)ws};
        unsigned char* scrp = ws + WS_SCR + (size_t)bx * 524288;
        pg8::EpiMerge E{scrp, scrp + 262144, (bf16_t*)(ws + WS_MG)};
        pg8::gemm_phase<pg8::EpiMerge, pg8::SchedMerge>((LAS unsigned char*)lds, 1024, S, E);
    }
    SEAM(4);

    for (int rep = 0; rep < NREP(5); ++rep) if (IN(5)) {
        if (rep) { __threadfence(); cg::this_grid().sync(); }
        pg8::SchedG S; S.init(M, 1024, G, bx, ws + WS_MG, WoT);
        pg8::EpiWo E{x_p, x_s, args.out};
        pg8::gemm_phase<pg8::EpiWo, pg8::SchedG>((LAS unsigned char*)lds, 1024, S, E);
    }
    SEAM(5);

    if (IN(6)) {
        bf16_t* HB = (bf16_t*)(ws + WS_HB);
        const f32x4* gp = (const f32x4*)args.in[14] + lane; const f32x4* bp = (const f32x4*)args.in[15] + lane;
        for (int m0 = gw * 4; m0 < M; m0 += NGW * 4) {
            f32x4 v[4][4];
#pragma unroll
            for (int u = 0; u < 4; ++u) { const f32x4* xr = (const f32x4*)(args.out + (size_t)(m0 + u) * 1024) + lane;
#pragma unroll
                for (int j = 0; j < 4; ++j) v[u][j] = xr[64 * j]; }
#pragma unroll
            for (int u = 0; u < 4; ++u) {
                float s_ = 0.f;
#pragma unroll
                for (int j = 0; j < 4; ++j) s_ += (v[u][j].x + v[u][j].y) + (v[u][j].z + v[u][j].w);
                const float mean = wave_sum(s_) * (1.f / 1024.f); float s2 = 0.f;
#pragma unroll
                for (int j = 0; j < 4; ++j) { v[u][j] = v[u][j] - mean; s2 += (v[u][j].x * v[u][j].x + v[u][j].y * v[u][j].y) + (v[u][j].z * v[u][j].z + v[u][j].w * v[u][j].w); }
                const float rstd = 1.f / sqrtf(wave_sum(s2) * (1.f / 1024.f) + LN_EPS);
                f32x4* xw = (f32x4*)(args.out + (size_t)(m0 + u) * 1024) + lane; u32x2* o8 = (u32x2*)(HB + (size_t)(m0 + u) * 1024) + lane;
#pragma unroll
                for (int j = 0; j < 4; ++j) { const f32x4 hv = v[u][j] * rstd * gp[64 * j] + bp[64 * j]; xw[64 * j] = hv;
                    u32x2 w; w.x = cvt_pk_bf16(hv.x, hv.y); w.y = cvt_pk_bf16(hv.z, hv.w); o8[64 * j] = w; }
            }
        }
    }
    SEAM(6);

    for (int rep = 0; rep < NREP(7); ++rep) if (IN(7)) {
        if (rep) { __threadfence(); cg::this_grid().sync(); }
        pg8::SchedG S; S.init(M, 2 * DFF, G, bx, ws + WS_HB, WguT);
        pg8::EpiGU E{(bf16_t*)(ws + WS_ACT)};
        pg8::gemm_phase<pg8::EpiGU, pg8::SchedG>((LAS unsigned char*)lds, 1024, S, E);
    }
    SEAM(7);

    if (IN(8)) {
        pg8::SchedG S; S.init(M, 1024, G, bx, ws + WS_ACT, WdT);
        pg8::EpiDown E{args.out};
        pg8::gemm_phase<pg8::EpiDown, pg8::SchedG>((LAS unsigned char*)lds, DFF, S, E);
    }
    SEAM(8);

    if (IN(9)) {
        const f32x4* gp = (const f32x4*)args.in[19] + lane; const f32x4* bp = (const f32x4*)args.in[20] + lane;
        for (int m0 = gw * 4; m0 < M; m0 += NGW * 4) {
            f32x4 v[4][4];
#pragma unroll
            for (int u = 0; u < 4; ++u) { const f32x4* xr = (const f32x4*)(args.out + (size_t)(m0 + u) * 1024) + lane;
#pragma unroll
                for (int j = 0; j < 4; ++j) v[u][j] = xr[64 * j]; }
#pragma unroll
            for (int u = 0; u < 4; ++u) {
                float s_ = 0.f;
#pragma unroll
                for (int j = 0; j < 4; ++j) s_ += (v[u][j].x + v[u][j].y) + (v[u][j].z + v[u][j].w);
                const float mean = wave_sum(s_) * (1.f / 1024.f); float s2 = 0.f;
#pragma unroll
                for (int j = 0; j < 4; ++j) { v[u][j] = v[u][j] - mean; s2 += (v[u][j].x * v[u][j].x + v[u][j].y * v[u][j].y) + (v[u][j].z * v[u][j].z + v[u][j].w * v[u][j].w); }
                const float rstd = 1.f / sqrtf(wave_sum(s2) * (1.f / 1024.f) + LN_EPS);
                f32x4* xw = (f32x4*)(args.out + (size_t)(m0 + u) * 1024) + lane;
#pragma unroll
                for (int j = 0; j < 4; ++j) xw[64 * j] = v[u][j] * rstd * gp[64 * j] + bp[64 * j];
            }
        }
    }
#ifdef DUMP_SRC
    SEAM(9);
    if (IN(10)) {
        const bf16_t* src = (const bf16_t*)(ws + (size_t)DUMP_SRC);
        for (size_t i = (size_t)bx * 512 + tid; i < (size_t)M * 1024 / 4; i += (size_t)G * 512) {
            const u32x2 w = *(const u32x2*)(src + i * 4);
            *(f32x4*)(args.out + i * 4) = (f32x4){bf2f(w.x & 0xffffu), bf2f(w.x >> 16), bf2f(w.y & 0xffffu), bf2f(w.y >> 16)};
        }
    }
#endif
#undef IN
#undef SEAM
}

#ifdef DUMP_SRC
constexpr int NPHASE = 11;
#else
constexpr int NPHASE = 10;
#endif
extern "C" void kernel_launch(void* const* d_in, const int* in_sizes, int n_in, void* d_out, int out_size, void* d_ws, size_t ws_size, hipStream_t stream) {
    static int grid = 0;
    if (grid == 0) {
        if (n_in != 21 || in_sizes[0] != M_P * DM || in_sizes[1] != M_S * DM || out_size != M * DM || ws_size < WS_END) {
            fprintf(stderr, "kernel_launch: shape mismatch (n_in %d, in0 %d, in1 %d, out %d, ws %zu)\n", n_in, n_in > 0 ? in_sizes[0] : -1, n_in > 1 ? in_sizes[1] : -1, out_size, ws_size); grid = -1; return; }
        int dev = 0, cus = 0, per_cu = 0;
        hipGetDevice(&dev); hipDeviceGetAttribute(&cus, hipDeviceAttributeMultiprocessorCount, dev);
        if (hipFuncSetAttribute((const void*)enc_fwd, hipFuncAttributeMaxDynamicSharedMemorySize, LDS_BYTES) != hipSuccess) { fprintf(stderr, "kernel_launch: hipFuncSetAttribute failed\n"); grid = -1; return; }
        if (hipOccupancyMaxActiveBlocksPerMultiprocessor(&per_cu, (const void*)enc_fwd, 512, LDS_BYTES) != hipSuccess || per_cu < 1) { fprintf(stderr, "kernel_launch: occupancy query says %d\n", per_cu); per_cu = 1; }
        (void)hipGetLastError();
        grid = cus * 1;
    }
    if (grid < 0) return;
    Args a{};
    for (int i = 0; i < 21; ++i) a.in[i] = (const float*)d_in[i];
    a.out = (float*)d_out; a.ws = (unsigned char*)d_ws;
#if MK_N_LAUNCHES == 1
    a.ph_lo = 0; a.ph_hi = NPHASE;
    void* kargs[] = {&a};
    hipError_t e = hipLaunchCooperativeKernel((const void*)enc_fwd, dim3(grid), dim3(512), kargs, LDS_BYTES, stream);
    if (e != hipSuccess) fprintf(stderr, "kernel_launch: cooperative launch failed: %s (grid %d)\n", hipGetErrorString(e), grid);
#else
    for (int p = 0; p < NPHASE; ++p) { a.ph_lo = p; a.ph_hi = p + 1; hipLaunchKernelGGL(enc_fwd, dim3(grid), dim3(512), LDS_BYTES, stream, a); }
#endif
}
```
